# Optimizing an MI355X kernel written in HIP

```python
import math
import jax, jax.numpy as jnp
from jax import lax
import numpy as np

D_MODEL = 1024
BATCH = 2
SEQ = 8192
DEPTH = 1

D_MIX = D_MODEL
G_WIDTH = D_MIX // 2
R_WIDTH = D_MIX - G_WIDTH
G_HEADS = 4
G_HEAD_DIM = G_WIDTH // G_HEADS
CHUNK = 128
R_HEADS = 8
R_HEAD_DIM = R_WIDTH // R_HEADS
CONV_W = 4
RG_C = 8.0
N_MEM = 256
X_HEADS = 4
X_HEAD_DIM = D_MODEL // X_HEADS
D_FF = int(math.ceil(D_MODEL * 8 / 3 / 256) * 256)
IN_COLS = 2 * G_WIDTH + 2 * R_WIDTH
EPS = 1e-6

kernel_name = "hybrid_gmlp_rglru_xattn_block"


def rms_norm(x, g):
    xf = x.astype(jnp.float32)
    y = xf * lax.rsqrt(jnp.mean(xf * xf, axis=-1, keepdims=True) + EPS)
    return (y * g.astype(jnp.float32)).astype(x.dtype)


def layer_norm(x, g, b):
    xf = x.astype(jnp.float32)
    mu = jnp.mean(xf, axis=-1, keepdims=True)
    var = jnp.mean(jnp.square(xf - mu), axis=-1, keepdims=True)
    y = (xf - mu) * lax.rsqrt(var + EPS)
    return (y * g.astype(jnp.float32) + b.astype(jnp.float32)).astype(x.dtype)


def gmlp_group(zu, zv, ln_v_g, ln_v_b, w_s, b_s):
    B, S, _ = zu.shape
    u = jax.nn.gelu(zu)
    v = layer_norm(jax.nn.gelu(zv), ln_v_g, ln_v_b)
    vb = v.reshape(B, S // CHUNK, CHUNK, G_HEADS, G_HEAD_DIM)
    causal = jnp.tril(jnp.ones((CHUNK, CHUNK), dtype=bool))
    ws = jnp.where(causal[None], w_s, jnp.zeros_like(w_s))
    s = jnp.einsum('htp,bnphd->bnthd', ws, vb) + b_s.T[None, None, :, :, None]
    return u * s.reshape(B, S, G_WIDTH)


def causal_dwconv(x, w, b):
    S = x.shape[1]
    xp = jnp.pad(x, ((0, 0), (CONV_W - 1, 0), (0, 0)))
    y = b
    for k in range(CONV_W):
        y = y + xp[:, k:k + S, :] * w[k]
    return y


def rglru_group(xr, gr, conv_w, conv_b, w_a, b_a, w_x, b_x, lam):
    B, S, _ = xr.shape
    xc = causal_dwconv(xr, conv_w, conv_b)
    xh = xc.reshape(B, S, R_HEADS, R_HEAD_DIM)
    r = jax.nn.sigmoid(jnp.einsum('bshi,hij->bshj', xh, w_a).reshape(B, S, R_WIDTH) + b_a)
    i = jax.nn.sigmoid(jnp.einsum('bshi,hij->bshj', xh, w_x).reshape(B, S, R_WIDTH) + b_x)
    log_a = -RG_C * r.astype(jnp.float32) * jax.nn.softplus(-lam.astype(jnp.float32))
    a = jnp.exp(log_a)
    mult = jnp.sqrt(-jnp.expm1(2.0 * log_a))
    bterm = mult * (i * xc).astype(jnp.float32)

    def combine(left, right):
        a_l, b_l = left
        a_r, b_r = right
        return a_l * a_r, a_r * b_l + b_r

    _, h = lax.associative_scan(combine, (a, bterm), axis=1)
    return jax.nn.gelu(gr) * h.astype(xr.dtype)


def token_mixer(h, w_in, ln_v_g, ln_v_b, w_s, b_s, conv_w, conv_b, w_a, b_a,
                w_x, b_x, lam, g_out_gmlp, g_out_lru, w_out):
    z = h @ w_in
    zu, zv, xr, gr = jnp.split(z, [G_WIDTH, 2 * G_WIDTH, 2 * G_WIDTH + R_WIDTH], axis=-1)
    y_g = gmlp_group(zu, zv, ln_v_g, ln_v_b, w_s, b_s)
    y_r = rglru_group(xr, gr, conv_w, conv_b, w_a, b_a, w_x, b_x, lam)
    y = jnp.concatenate([rms_norm(y_g, g_out_gmlp), rms_norm(y_r, g_out_lru)], axis=-1)
    return y @ w_out


def mem_cross_attention(h, m, w_q, w_kv, w_o):
    B, S, _ = h.shape
    q = (h @ w_q).reshape(B, S, X_HEADS, X_HEAD_DIM)
    k, v = jnp.split(m @ w_kv, 2, axis=-1)
    k = k.reshape(B, N_MEM, X_HEADS, X_HEAD_DIM)
    v = v.reshape(B, N_MEM, X_HEADS, X_HEAD_DIM)
    scores = jnp.einsum('bshd,bmhd->bhsm', q, k).astype(jnp.float32) * (X_HEAD_DIM ** -0.5)
    p = jax.nn.softmax(scores, axis=-1).astype(v.dtype)
    o = jnp.einsum('bhsm,bmhd->bshd', p, v).reshape(B, S, X_HEADS * X_HEAD_DIM)
    return o @ w_o


def swiglu(h, w_gate, w_up, w_down):
    return (jax.nn.silu(h @ w_gate) * (h @ w_up)) @ w_down


def setup_inputs(seed: int = 0) -> dict:
    key = jax.random.key(seed)
    ks = iter(jax.random.split(key, 40))
    f32 = jnp.float32

    def nrm(shape, scale):
        return jax.random.normal(next(ks), shape, f32) * scale

    def gain(shape):
        return 1.0 + 0.02 * jax.random.normal(next(ks), shape, f32)

    Lr = DEPTH
    u = jax.random.uniform(next(ks), (Lr, R_WIDTH), f32, 0.9, 0.999)
    a0 = u ** (1.0 / RG_C)
    lam = jnp.log(a0) - jnp.log1p(-a0)
    return {
        "x": jax.random.normal(next(ks), (BATCH, SEQ, D_MODEL), f32),
        "mem": jax.random.normal(next(ks), (BATCH, N_MEM, D_MODEL), f32),
        "w_in": nrm((Lr, D_MODEL, IN_COLS), D_MODEL ** -0.5),
        "ln_v_g": gain((Lr, G_WIDTH)),
        "ln_v_b": nrm((Lr, G_WIDTH), 0.02),
        "w_s": nrm((Lr, G_HEADS, CHUNK, CHUNK), CHUNK ** -0.5),
        "b_s": gain((Lr, G_HEADS, CHUNK)),
        "conv_w": nrm((Lr, CONV_W, R_WIDTH), CONV_W ** -0.5),
        "conv_b": nrm((Lr, R_WIDTH), 0.02),
        "w_a": nrm((Lr, R_HEADS, R_HEAD_DIM, R_HEAD_DIM), R_HEAD_DIM ** -0.5),
        "b_a": nrm((Lr, R_WIDTH), 0.02),
        "w_x": nrm((Lr, R_HEADS, R_HEAD_DIM, R_HEAD_DIM), R_HEAD_DIM ** -0.5),
        "b_x": nrm((Lr, R_WIDTH), 0.02),
        "lam": lam,
        "g_out_gmlp": gain((Lr, G_WIDTH)),
        "g_out_lru": gain((Lr, R_WIDTH)),
        "w_out": nrm((Lr, D_MIX, D_MODEL), D_MIX ** -0.5),
        "w_q": nrm((Lr, D_MODEL, X_HEADS * X_HEAD_DIM), D_MODEL ** -0.5),
        "w_kv": nrm((Lr, D_MODEL, 2 * X_HEADS * X_HEAD_DIM), D_MODEL ** -0.5),
        "w_o": nrm((Lr, X_HEADS * X_HEAD_DIM, D_MODEL), (X_HEADS * X_HEAD_DIM) ** -0.5),
        "w_gate": nrm((Lr, D_MODEL, D_FF), D_MODEL ** -0.5),
        "w_up": nrm((Lr, D_MODEL, D_FF), D_MODEL ** -0.5),
        "w_down": nrm((Lr, D_FF, D_MODEL), D_FF ** -0.5),
        "n_pre_mix": gain((Lr, D_MODEL)),
        "n_post_mix": gain((Lr, D_MODEL)),
        "n_pre_x": gain((Lr, D_MODEL)),
        "n_mem": gain((Lr, D_MODEL)),
        "n_post_x": gain((Lr, D_MODEL)),
        "n_pre_ffn": gain((Lr, D_MODEL)),
        "n_post_ffn": gain((Lr, D_MODEL)),
    }


def reference(x, mem, w_in, ln_v_g, ln_v_b, w_s, b_s, conv_w, conv_b, w_a, b_a,
              w_x, b_x, lam, g_out_gmlp, g_out_lru, w_out, w_q, w_kv, w_o,
              w_gate, w_up, w_down, n_pre_mix, n_post_mix, n_pre_x, n_mem,
              n_post_x, n_pre_ffn, n_post_ffn):
    h = x
    for l in range(DEPTH):
        y = token_mixer(rms_norm(h, n_pre_mix[l]), w_in[l], ln_v_g[l], ln_v_b[l],
                        w_s[l], b_s[l], conv_w[l], conv_b[l], w_a[l], b_a[l],
                        w_x[l], b_x[l], lam[l], g_out_gmlp[l], g_out_lru[l], w_out[l])
        h = h + rms_norm(y, n_post_mix[l])
        y = mem_cross_attention(rms_norm(h, n_pre_x[l]), rms_norm(mem, n_mem[l]),
                                w_q[l], w_kv[l], w_o[l])
        h = h + rms_norm(y, n_post_x[l])
        y = swiglu(rms_norm(h, n_pre_ffn[l]), w_gate[l], w_up[l], w_down[l])
        h = h + rms_norm(y, n_post_ffn[l])
    return h
```

```cpp
#include <hip/hip_runtime.h>
#include <cstdio>
#include <cstdint>
namespace pg8 {
#define PG8_LAS __attribute__((address_space(3)))
typedef unsigned short bf16_t;
typedef short bf16x8 __attribute__((ext_vector_type(8)));
typedef float f32x4 __attribute__((ext_vector_type(4)));
typedef unsigned u32x4 __attribute__((ext_vector_type(4)));
constexpr int BM = 256, BK = 64, HALF = 128, HTB = HALF * BK * 2  , STAGE_BYTES = 8 * HTB, NXCD = 8, WGM = 8;

__host__ __device__ __forceinline__ int lds_byte(int r, int c) { const int st = (r >> 4) * 2 + (c >> 5), rr = r & 15, cc = c & 31, ob = rr * 64 + cc * 2; return st * 1024 + (ob ^ (((ob >> 9) & 1) << 5)); }
__host__ __device__ __forceinline__ void stage_rc(int b, int& R, int& C) { const int st = b / 1024, sb = b % 1024, swz = sb ^ (((sb >> 9) & 1) << 5); R = (st >> 1) * 16 + swz / 64; C = (st & 1) * 32 + (swz % 64) / 2; }
__host__ __device__ __forceinline__ int perm32(int rho) { const int n = rho >> 4, i = rho & 15; return 8 * (i >> 2) + 4 * n + (i & 3); }

struct Unit { int pm, pn; };
struct Gemm { const bf16_t* A; const bf16_t* Bt; int M, N, K; };

struct StaticOrder {
    int nM, nN, nwg, G, c;
    __host__ __device__ void init(int M, int N, int G_, int c_) { nM = M / BM; nN = N / BM; nwg = nM * nN; G = G_; c = c_; }
    __host__ __device__ bool next(int i, Unit& u) const {
        const long L = (long)i * G + c; if (L >= nwg) return false;
        int wgid = (int)L; { const int q = nwg / NXCD, r = nwg % NXCD, xcd = wgid % NXCD, off = wgid / NXCD; wgid = (xcd < r ? xcd * (q + 1) : r * (q + 1) + (xcd - r) * q) + off; }
        const int nig = WGM * nN, gid = wgid / nig, fm = gid * WGM, gsz = (nM - fm) < WGM ? (nM - fm) : WGM;
        u.pm = fm + ((wgid % nig) % gsz); u.pn = (wgid % nig) / gsz; return true;
    }
    __device__ __forceinline__ void a_ready(const Unit&) const {}
    __device__ __forceinline__ void done(const Unit&) const {}
};

__device__ __forceinline__ unsigned cvt_pk_bf16(float lo, float hi) { unsigned r; asm volatile("v_cvt_pk_bf16_f32 %0, %1, %2" : "=v"(r) : "v"(lo), "v"(hi)); return r; }
typedef float f32x2 __attribute__((ext_vector_type(2)));
__device__ __forceinline__ f32x2 gelu_pk(f32x2 v) {
    const f32x2 av = __builtin_elementwise_abs(v), d = av * 0.2316418882f + 1.0f;
    f32x2 t; t.x = __builtin_amdgcn_rcpf(d.x); t.y = __builtin_amdgcn_rcpf(d.y);
    f32x2 q = t * 0.5307027145f + (-0.7265760135f); q = q * t + 0.7107068705f; q = q * t + (-0.142248368f); q = q * t + 0.127414796f; q = q * t;
    const f32x2 s = (v * v) * (-0.72134752044f);
    f32x2 e; e.x = __builtin_amdgcn_exp2f(s.x); e.y = __builtin_amdgcn_exp2f(s.y);
    const f32x2 m = v * (q * e), r = v - m;
    f32x2 o; o.x = v.x < 0.f ? m.x : r.x; o.y = v.y < 0.f ? m.y : r.y; return o;
}
__device__ __forceinline__ float gelu_tanh1(float x) {
    const float z = x * (1.0f + 0.044715f * x * x) * (-1.5957691216057308f * 1.4426950408889634f);
    return x * __builtin_amdgcn_rcpf(1.0f + __builtin_amdgcn_exp2f(z));
}
__device__ __forceinline__ float sigmoid1(float x) { return __builtin_amdgcn_rcpf(1.0f + __builtin_amdgcn_exp2f(x * -1.4426950408889634f)); }
struct EpiBf {
    static constexpr bool PERM = true, AFTER_DRAIN = false;
    bf16_t* O; int ldc; unsigned gelu_mask; float scale;
    __device__ __forceinline__ void operator()(const f32x4 (&acc)[2][2][4][2], const Unit& u, int wr, int wc, int fr, int fq) const {
        const int row0 = u.pm * BM + wr * 64 + fr, col0 = u.pn * BM + wc * 32 + 8 * fq;
        const bool act = (gelu_mask >> u.pn) & 1u;
#pragma unroll
        for (int ai = 0; ai < 2; ++ai)
#pragma unroll
            for (int m = 0; m < 4; ++m) { bf16_t* rowp = O + (size_t)(row0 + ai * HALF + m * 16) * ldc + col0;
#pragma unroll
                for (int bj = 0; bj < 2; ++bj) { f32x4 v0 = acc[ai][bj][m][0], v1 = acc[ai][bj][m][1];
                    if (act) {
#pragma unroll
                        for (int e = 0; e < 4; ++e) { v0[e] = gelu_tanh1(v0[e]); v1[e] = gelu_tanh1(v1[e]); } }
                    v0 = v0 * scale; v1 = v1 * scale; u32x4 w; w.x = cvt_pk_bf16(v0[0], v0[1]); w.y = cvt_pk_bf16(v0[2], v0[3]); w.z = cvt_pk_bf16(v1[0], v1[1]); w.w = cvt_pk_bf16(v1[2], v1[3]);
                    *(u32x4*)(rowp + bj * HALF) = w; } }
    }
};
struct EpiYss {
    static constexpr bool PERM = true, AFTER_DRAIN = false;
    bf16_t* O; int ldc; float* rowss;
    __device__ __forceinline__ void operator()(const f32x4 (&acc)[2][2][4][2], const Unit& u, int wr, int wc, int fr, int fq) const {
        const int row0 = u.pm * BM + wr * 64 + fr, col0 = u.pn * BM + wc * 32 + 8 * fq;
#pragma unroll
        for (int ai = 0; ai < 2; ++ai)
#pragma unroll
            for (int m = 0; m < 4; ++m) { const int row = row0 + ai * HALF + m * 16; bf16_t* rowp = O + (size_t)row * ldc + col0; float ss = 0.f;
#pragma unroll
                for (int bj = 0; bj < 2; ++bj) { const f32x4 v0 = acc[ai][bj][m][0], v1 = acc[ai][bj][m][1];
                    ss += (v0[0] * v0[0] + v0[1] * v0[1]) + (v0[2] * v0[2] + v0[3] * v0[3]) + (v1[0] * v1[0] + v1[1] * v1[1]) + (v1[2] * v1[2] + v1[3] * v1[3]);
                    u32x4 w; w.x = cvt_pk_bf16(v0[0], v0[1]); w.y = cvt_pk_bf16(v0[2], v0[3]); w.z = cvt_pk_bf16(v1[0], v1[1]); w.w = cvt_pk_bf16(v1[2], v1[3]);
                    *(u32x4*)(rowp + bj * HALF) = w; }
                ss += __shfl_xor(ss, 16); ss += __shfl_xor(ss, 32);
                if (fq == 0) __hip_atomic_fetch_add(rowss + row, ss, __ATOMIC_RELAXED, __HIP_MEMORY_SCOPE_AGENT); }
    }
};
struct EpiGU {
    static constexpr bool PERM = true, AFTER_DRAIN = false;
    bf16_t* O; int ldc;
    __device__ __forceinline__ void operator()(const f32x4 (&acc)[2][2][4][2], const Unit& u, int wr, int wc, int fr, int fq) const {
        const int row0 = u.pm * BM + wr * 64 + fr, col0 = u.pn * HALF + wc * 32 + 8 * fq;
#pragma unroll
        for (int ai = 0; ai < 2; ++ai)
#pragma unroll
            for (int m = 0; m < 4; ++m) { bf16_t* rowp = O + (size_t)(row0 + ai * HALF + m * 16) * ldc + col0;
                f32x4 r0, r1;
#pragma unroll
                for (int e = 0; e < 4; ++e) { const float g0 = acc[ai][0][m][0][e], g1 = acc[ai][0][m][1][e];
                    r0[e] = g0 * sigmoid1(g0) * acc[ai][1][m][0][e]; r1[e] = g1 * sigmoid1(g1) * acc[ai][1][m][1][e]; }
                u32x4 w; w.x = cvt_pk_bf16(r0[0], r0[1]); w.y = cvt_pk_bf16(r0[2], r0[3]); w.z = cvt_pk_bf16(r1[0], r1[1]); w.w = cvt_pk_bf16(r1[2], r1[3]);
                *(u32x4*)rowp = w; }
    }
};
struct EpiKV {
    static constexpr bool PERM = true, AFTER_DRAIN = false;
    bf16_t* Kb; bf16_t* VT;
    __device__ __forceinline__ void operator()(const f32x4 (&acc)[2][2][4][2], const Unit& u, int wr, int wc, int fr, int fq) const {
        const int row0 = u.pm * BM + wr * 64 + fr, col0 = u.pn * BM + wc * 32 + 8 * fq;
        if (u.pn < 4) {
#pragma unroll
            for (int ai = 0; ai < 2; ++ai)
#pragma unroll
                for (int m = 0; m < 4; ++m) { bf16_t* rowp = Kb + (size_t)(row0 + ai * HALF + m * 16) * 1024 + col0;
#pragma unroll
                    for (int bj = 0; bj < 2; ++bj) { const f32x4 v0 = acc[ai][bj][m][0], v1 = acc[ai][bj][m][1];
                        u32x4 w; w.x = cvt_pk_bf16(v0[0], v0[1]); w.y = cvt_pk_bf16(v0[2], v0[3]); w.z = cvt_pk_bf16(v1[0], v1[1]); w.w = cvt_pk_bf16(v1[2], v1[3]);
                        *(u32x4*)(rowp + bj * HALF) = w; } }
        } else {
#pragma unroll
            for (int ai = 0; ai < 2; ++ai)
#pragma unroll
                for (int m = 0; m < 4; ++m) { const int mm = wr * 64 + ai * HALF + m * 16 + fr;
                    const int pos = (mm & ~31) + 8 * ((mm >> 2) & 3) + 4 * ((mm >> 4) & 1) + (mm & 3);
                    bf16_t* base = VT + (size_t)u.pm * 1024 * 256 + pos;
#pragma unroll
                    for (int bj = 0; bj < 2; ++bj)
#pragma unroll
                        for (int n = 0; n < 2; ++n)
#pragma unroll
                            for (int e = 0; e < 4; ++e) { const int hd = col0 - 1024 + bj * HALF + 4 * n + e;
                                base[(size_t)hd * 256] = (bf16_t)(cvt_pk_bf16(acc[ai][bj][m][n][e], 0.f) & 0xffffu); } }
        }
    }
};
template <class Epi, class Sched, bool ALIGN_EPI = false, bool SP2 = false>
__device__ __forceinline__ void gemm_phase(PG8_LAS unsigned char* lds, const Gemm g, const Sched& S, const Epi& E) {
    int tid_l = threadIdx.x; asm volatile("" : "+v"(tid_l));
    const int tid = tid_l, wid = __builtin_amdgcn_readfirstlane(tid >> 6), lane = tid & 63, wr = wid >> 2, wc = wid & 3, fr = lane & 15, fq = lane >> 4;
    const int K = g.K, nt = K / BK;
    unsigned voffA[2], voffB[2];
#pragma unroll
    for (int i = 0; i < 2; ++i) { int R, C; stage_rc(tid * 16 + i * 8192, R, C); const int Rb = Epi::PERM ? ((R & ~31) + perm32(R & 31)) : R;
        voffA[i] = (unsigned)(R * K + C) * 2u; voffB[i] = (unsigned)(Rb * K + C) * 2u; }
    const size_t kstep = (size_t)(BK * 2);
    const size_t hstep = (size_t)HALF * K * 2;
    const size_t tstep = 2 * hstep;
    const unsigned ldsw = (unsigned)wid * 1024u;
    const int aoff = lds_byte(wr * 64 + fr, fq * 8), boff = lds_byte(wc * 32 + fr, fq * 8);
#define PG8_SA(b, h) (((b) * 2 + (h)) * HTB)
#define PG8_SB(b, h) ((4 + (b) * 2 + (h)) * HTB)
#define PG8_STAGE(bufoff, gbase, voff) do { _Pragma("unroll") for (int _i = 0; _i < 2; ++_i) \
        __builtin_amdgcn_global_load_lds((const unsigned*)((const char*)(gbase) + (voff)[_i]), (PG8_LAS unsigned*)(lds + (bufoff) + ldsw + _i * 8192), 16, 0, 0); } while (0)
#define PG8_LDA(dst, b, h) do { _Pragma("unroll") for (int m = 0; m < 4; ++m) _Pragma("unroll") for (int k = 0; k < 2; ++k) dst[m][k] = *(const PG8_LAS bf16x8*)(lds + PG8_SA(b, h) + aoff + m * 2048 + k * 1024); } while (0)
#define PG8_LDB(dst, b, h) do { _Pragma("unroll") for (int n = 0; n < 2; ++n) _Pragma("unroll") for (int k = 0; k < 2; ++k) dst[n][k] = *(const PG8_LAS bf16x8*)(lds + PG8_SB(b, h) + boff + n * 2048 + k * 1024); } while (0)
#define PG8_MMA(ai, bj, At, Bt) do { __builtin_amdgcn_s_setprio(1); _Pragma("unroll") for (int m = 0; m < 4; ++m) _Pragma("unroll") for (int n = 0; n < 2; ++n) _Pragma("unroll") for (int k = 0; k < 2; ++k) \
        acc[ai][bj][m][n] = __builtin_amdgcn_mfma_f32_16x16x32_bf16(Bt[n][k], At[m][k], acc[ai][bj][m][n], 0, 0, 0); __builtin_amdgcn_s_setprio(0); } while (0)
#define PG8_WAIT_V(n) asm volatile("s_waitcnt vmcnt(" #n ")" ::: "memory")
#define PG8_WAIT_L(n) asm volatile("s_waitcnt lgkmcnt(" #n ")" ::: "memory")
#define PG8_BAR __builtin_amdgcn_s_barrier()
#define PG8_SCHED __builtin_amdgcn_sched_barrier(0)
    Unit cur, nxt; int ui = 0;
    if (!S.next(0, cur)) return;
    f32x4 acc[2][2][4][2];
#pragma unroll
    for (int a = 0; a < 2; ++a)
#pragma unroll
        for (int b = 0; b < 2; ++b)
#pragma unroll
            for (int m = 0; m < 4; ++m)
#pragma unroll
                for (int n = 0; n < 2; ++n) acc[a][b][m][n] = (f32x4){0.f, 0.f, 0.f, 0.f};
    bf16x8 At[4][2], B0[2][2], B1[2][2];
    const char* cA = (const char*)g.A + (size_t)cur.pm * tstep; const char* cB = (const char*)g.Bt + (size_t)cur.pn * tstep;
    S.a_ready(cur);
    if constexpr (SP2) {
        PG8_STAGE(PG8_SB(0, 0), cB, voffB); PG8_STAGE(PG8_SB(0, 1), cB + hstep, voffB); PG8_STAGE(PG8_SA(0, 0), cA, voffA); PG8_STAGE(PG8_SA(0, 1), cA + hstep, voffA);
        if (wr == 1) PG8_BAR;
        PG8_WAIT_V(2); PG8_BAR;
        PG8_STAGE(PG8_SB(1, 0), cB + kstep, voffB); PG8_STAGE(PG8_SA(1, 0), cA + kstep, voffA); PG8_STAGE(PG8_SB(1, 1), cB + hstep + kstep, voffB);
        PG8_WAIT_V(6); PG8_BAR;
    } else {
        PG8_STAGE(PG8_SB(0, 0), cB, voffB); PG8_STAGE(PG8_SA(0, 0), cA, voffA); PG8_STAGE(PG8_SB(0, 1), cB + hstep, voffB); PG8_STAGE(PG8_SA(0, 1), cA + hstep, voffA);
        if (wr == 1) PG8_BAR;
        PG8_WAIT_V(4); PG8_BAR;
        PG8_STAGE(PG8_SB(1, 0), cB + kstep, voffB); PG8_STAGE(PG8_SA(1, 0), cA + kstep, voffA); PG8_STAGE(PG8_SB(1, 1), cB + hstep + kstep, voffB);
        PG8_WAIT_V(6); PG8_BAR;
    }
    for (;;) {
        const bool has_next = S.next(ui + 1, nxt);
        const char* nA = has_next ? (const char*)g.A + (size_t)nxt.pm * tstep : cA; const char* nB = has_next ? (const char*)g.Bt + (size_t)nxt.pn * tstep : cB;
        for (int t = 0; t < nt; t += 2) {
            const bool last = (t == nt - 2);
            const char* a1 = cA + (size_t)(t + 1) * kstep;
            const char* a2 = last ? nA : cA + (size_t)(t + 2) * kstep; const char* b2 = last ? nB : cB + (size_t)(t + 2) * kstep;
            const char* a3 = a2 + kstep; const char* b3 = b2 + kstep;
            if (last && has_next) S.a_ready(nxt);
            if constexpr (SP2) {
            PG8_LDB(B0, 0, 0); PG8_LDB(B1, 0, 1); PG8_SCHED; PG8_LDA(At, 0, 0); PG8_STAGE(PG8_SA(1, 1), a1 + hstep, voffA);
            PG8_WAIT_V(8); PG8_WAIT_L(0); PG8_BAR; PG8_MMA(0, 0, At, B0); PG8_MMA(0, 1, At, B1); PG8_BAR; PG8_SCHED;
            PG8_LDA(At, 0, 1); PG8_STAGE(PG8_SB(0, 0), b2, voffB); PG8_STAGE(PG8_SB(0, 1), b2 + hstep, voffB); PG8_STAGE(PG8_SA(0, 0), a2, voffA);
            PG8_WAIT_V(8); PG8_WAIT_L(0); PG8_BAR; PG8_MMA(1, 0, At, B0); PG8_MMA(1, 1, At, B1); PG8_BAR; PG8_SCHED;
            PG8_LDB(B0, 1, 0); PG8_LDB(B1, 1, 1); PG8_SCHED; PG8_LDA(At, 1, 0); PG8_STAGE(PG8_SA(0, 1), a2 + hstep, voffA);
            PG8_WAIT_V(8); PG8_WAIT_L(0); PG8_BAR; PG8_MMA(0, 0, At, B0); PG8_MMA(0, 1, At, B1); PG8_BAR; PG8_SCHED;
            PG8_LDA(At, 1, 1); PG8_STAGE(PG8_SB(1, 0), b3, voffB); PG8_STAGE(PG8_SB(1, 1), b3 + hstep, voffB); PG8_STAGE(PG8_SA(1, 0), a3, voffA);
            PG8_WAIT_V(8); PG8_WAIT_L(0); PG8_BAR; PG8_MMA(1, 0, At, B0); PG8_MMA(1, 1, At, B1); PG8_BAR; PG8_SCHED;
            } else {
            PG8_LDB(B0, 0, 0); PG8_SCHED; PG8_LDA(At, 0, 0); PG8_STAGE(PG8_SA(1, 1), a1 + hstep, voffA);
            PG8_WAIT_L(8); PG8_BAR; PG8_WAIT_L(0); PG8_MMA(0, 0, At, B0); PG8_BAR; PG8_SCHED;
            PG8_LDB(B1, 0, 1); PG8_STAGE(PG8_SB(0, 0), b2, voffB);
            PG8_BAR; PG8_WAIT_L(0); PG8_MMA(0, 1, At, B1); PG8_BAR;
            PG8_LDA(At, 0, 1); PG8_STAGE(PG8_SA(0, 0), a2, voffA);
            PG8_BAR; PG8_WAIT_L(0); PG8_MMA(1, 0, At, B0); PG8_BAR; PG8_SCHED;
            PG8_STAGE(PG8_SB(0, 1), b2 + hstep, voffB);
            PG8_WAIT_V(6); PG8_BAR; PG8_MMA(1, 1, At, B1); PG8_BAR;
            PG8_LDB(B0, 1, 0); PG8_SCHED; PG8_LDA(At, 1, 0); PG8_STAGE(PG8_SA(0, 1), a2 + hstep, voffA);
            PG8_WAIT_L(8); PG8_BAR; PG8_WAIT_L(0); PG8_MMA(0, 0, At, B0); PG8_BAR; PG8_SCHED;
            PG8_LDB(B1, 1, 1); PG8_STAGE(PG8_SB(1, 0), b3, voffB);
            PG8_BAR; PG8_WAIT_L(0); PG8_MMA(0, 1, At, B1); PG8_BAR;
            PG8_LDA(At, 1, 1); PG8_STAGE(PG8_SA(1, 0), a3, voffA);
            PG8_BAR; PG8_WAIT_L(0); PG8_MMA(1, 0, At, B0); PG8_BAR; PG8_SCHED;
            PG8_STAGE(PG8_SB(1, 1), b3 + hstep, voffB);
            PG8_WAIT_V(6); PG8_BAR; PG8_MMA(1, 1, At, B1); PG8_BAR;
            }
        }
        if constexpr (ALIGN_EPI) { if (wr == 0) PG8_BAR; }
        if constexpr (!Epi::AFTER_DRAIN) { E(acc, cur, wr, wc, fr, fq); S.done(cur); }
        if (!has_next) break;
#pragma unroll
        for (int a = 0; a < 2; ++a)
#pragma unroll
            for (int b = 0; b < 2; ++b)
#pragma unroll
                for (int m = 0; m < 4; ++m)
#pragma unroll
                    for (int n = 0; n < 2; ++n) acc[a][b][m][n] = (f32x4){0.f, 0.f, 0.f, 0.f};
        cur = nxt; cA = nA; cB = nB; ++ui;
        if constexpr (ALIGN_EPI) { if (wr == 1) PG8_BAR; }
    }
    PG8_WAIT_V(0);
    if constexpr (!ALIGN_EPI) { if (wr == 0) PG8_BAR; }
    PG8_BAR;
    if constexpr (Epi::AFTER_DRAIN) { E.fused(acc, cur, wr, wc, fr, fq, lds, wid, lane); S.done(cur); }
#undef PG8_SA
#undef PG8_SB
#undef PG8_STAGE
#undef PG8_LDA
#undef PG8_LDB
#undef PG8_MMA
#undef PG8_WAIT_V
#undef PG8_WAIT_L
#undef PG8_BAR
#undef PG8_SCHED
}
}
constexpr int NWAVES = 8;
constexpr int M = 16384, D = 1024, SEQ = 8192, NIN = 2048, GWID = 512, DFF = 2816, NMEM = 256;
constexpr float EPS = 1e-6f;
constexpr size_t MiB = 1u << 20;
constexpr size_t WS_CTL = 0, CTL_ZERO_BYTES = 256 * 1024;
constexpr size_t WS_MEMN = 1 * MiB, WS_KB = 2 * MiB, WS_VT = 3 * MiB, WS_AGG = 4 * MiB, WS_LRUW = 5 * MiB;
constexpr size_t WS_WIN = 8 * MiB, WS_WKV = 12 * MiB, WS_WOUT = 16 * MiB, WS_WQ = 18 * MiB, WS_WO = 20 * MiB, WS_WGU = 22 * MiB, WS_WDN = 33 * MiB;
constexpr size_t WS_XN = 40 * MiB, WS_Z = 72 * MiB, WS_YCAT = 136 * MiB, WS_Y = 168 * MiB, WS_QO = 200 * MiB, WS_ACT = 72 * MiB, WS_END = 232 * MiB;
constexpr int CW_BAR = 4096, CW_ROWSS = 16384;
constexpr int RING_BYTES = 131072, LDSCTL_OFF = RING_BYTES, MISC_OFF = LDSCTL_OFF + 320, LDS_BYTES = 147456;

#define GAS __attribute__((address_space(1)))
#define LAS __attribute__((address_space(3)))
typedef unsigned short bf16;
typedef unsigned v4u __attribute__((ext_vector_type(4)));
typedef unsigned v2u __attribute__((ext_vector_type(2)));
typedef float f32x4 __attribute__((ext_vector_type(4)));
typedef short bf16x8 __attribute__((ext_vector_type(8)));
#define LDS_WAIT() asm volatile("s_waitcnt lgkmcnt(0)" ::: "memory")
#define CFENCE() asm volatile("" ::: "memory")
#define SBAR() do { asm volatile("" ::: "memory"); __builtin_amdgcn_sched_barrier(0); } while (0)
__device__ __forceinline__ unsigned pk2(float lo, float hi) { return pg8::cvt_pk_bf16(lo, hi); }
__device__ __forceinline__ float bflo(unsigned w) { return __uint_as_float(w << 16); }
__device__ __forceinline__ float bfhi(unsigned w) { return __uint_as_float(w & 0xffff0000u); }
__device__ __forceinline__ float bf1(unsigned short s) { return __uint_as_float((unsigned)s << 16); }
__device__ __forceinline__ void unpack8(const v4u q, float (&x)[8]) { x[0] = bflo(q.x); x[1] = bfhi(q.x); x[2] = bflo(q.y); x[3] = bfhi(q.y); x[4] = bflo(q.z); x[5] = bfhi(q.z); x[6] = bflo(q.w); x[7] = bfhi(q.w); }
__device__ __forceinline__ bf16x8 pack8(const float (&x)[8]) { v4u w; w.x = pk2(x[0], x[1]); w.y = pk2(x[2], x[3]); w.z = pk2(x[4], x[5]); w.w = pk2(x[6], x[7]); return __builtin_bit_cast(bf16x8, w); }
__device__ __forceinline__ float wave_sum(float v) {
#pragma unroll
    for (int o = 1; o < 64; o <<= 1) v += __shfl_xor(v, o);
    return v;
}
#define MFMA16(a, b, c) __builtin_amdgcn_mfma_f32_16x16x32_bf16((a), (b), (c), 0, 0, 0)

#define XB_TMO      128
#define XB_XCNT(j)  (256  + 64 * (j))
#define XB_XSUB(j)  (1280 + 64 * (j))
#define XB_XGEN(j)  (2304 + 64 * (j))
#define XB_TOP      3328
#define XB_TOPGEN   3392
#define XCD_BAR_WORDS 3456
#define XB_SPIN_CAP (1u << 18)

__device__ __forceinline__ unsigned xb_ld(unsigned* p)              { return __hip_atomic_load(p, __ATOMIC_RELAXED, __HIP_MEMORY_SCOPE_AGENT); }
__device__ __forceinline__ unsigned xb_add(unsigned* p, unsigned v) { return __hip_atomic_fetch_add(p, v, __ATOMIC_RELAXED, __HIP_MEMORY_SCOPE_AGENT); }
__device__ __forceinline__ unsigned xb_xcc_id() { return (unsigned)__builtin_amdgcn_s_getreg((3 << 11) | 20) & 0xFu; }
#define XB_SPIN(cond, bar) do { unsigned _sp = 0; while (cond) { __builtin_amdgcn_s_sleep(1); \
    if ((++_sp & 255u) == 0u) { if (xb_ld(&(bar)[XB_TMO])) break; if (_sp > XB_SPIN_CAP) { atomicAdd(&(bar)[XB_TMO], 1u); break; } } } } while (0)

struct XcdBarrier {
    unsigned* bar; unsigned x;
    volatile LAS unsigned* st;
};

__device__ __forceinline__ XcdBarrier xcd_barrier_post(unsigned* bar, volatile LAS unsigned* st) {
    XcdBarrier b; b.bar = bar; b.x = xb_xcc_id(); b.st = st;
    if (threadIdx.x == 0) (void)xb_add(&bar[XB_XCNT(b.x)], 1u);
    return b;
}
__device__ __forceinline__ void xcd_barrier_complete(unsigned* bar, unsigned x, unsigned& nloc, unsigned& nx) {
    const unsigned G = gridDim.x * gridDim.y * gridDim.z;
    unsigned sum, cnt, mine, sp = 0u;
    for (;;) {
        sum = 0u; cnt = 0u; mine = 0u;
#pragma unroll
        for (unsigned j = 0; j < 16; ++j) { const unsigned c = xb_ld(&bar[XB_XCNT(j)]); sum += c; cnt += (c > 0u) ? 1u : 0u; mine = (j == x) ? c : mine; }
        if (sum == G) break;
        __builtin_amdgcn_s_sleep(1);
        if ((++sp & 255u) == 0u) { if (xb_ld(&bar[XB_TMO])) break; if (sp > XB_SPIN_CAP) { atomicAdd(&bar[XB_TMO], 1u); break; } }
    }
    nloc = mine > 0u ? mine : 1u; nx = cnt > 0u ? cnt : 1u;
}

__device__ __forceinline__ void xcd_barrier(const XcdBarrier& b) {
    asm volatile("s_waitcnt vmcnt(0)" ::: "memory");
    __syncthreads();
    if (threadIdx.x == 0) {
        unsigned* bar = b.bar;
        __builtin_amdgcn_s_waitcnt(0);
        unsigned nloc = b.st[0], nx = b.st[1];
        if (nloc == 0u) { xcd_barrier_complete(bar, b.x, nloc, nx); b.st[0] = nloc; b.st[1] = nx; }
        const unsigned old = xb_add(&bar[XB_XSUB(b.x)], 1u);
        const unsigned gen = old / nloc;
        if (old + 1u == (gen + 1u) * nloc) {
            __builtin_amdgcn_fence(__ATOMIC_RELEASE, "agent");
            asm volatile("s_waitcnt vmcnt(0)" ::: "memory");
            const unsigned og = xb_add(&bar[XB_TOP], 1u);
            const unsigned tg = og / nx;
            if (og + 1u == (tg + 1u) * nx) xb_add(&bar[XB_TOPGEN], 1u);
            else XB_SPIN(xb_ld(&bar[XB_TOPGEN]) == tg, bar);
            __builtin_amdgcn_fence(__ATOMIC_ACQUIRE, "agent");
            xb_add(&bar[XB_XGEN(b.x)], 1u);
            asm volatile("s_waitcnt vmcnt(0)" ::: "memory");
        } else {
            XB_SPIN(xb_ld(&bar[XB_XGEN(b.x)]) == gen, bar);
            __builtin_amdgcn_fence(__ATOMIC_ACQUIRE, "agent");
            asm volatile("s_waitcnt vmcnt(0)" ::: "memory");
        }
    }
    __syncthreads();
}


struct Args { const float* in[30]; float* out; unsigned char* ws; };

__device__ __forceinline__ void p0_transpose_item(const float* W, int K, int N, bf16* WT, int dst_row0, LAS float* scr, int k0, int n0, int lane) {
#pragma unroll 8
    for (int i = 0; i < 32; ++i) { const int kk = 2 * i + (lane >> 5); scr[kk * 33 + (lane & 31)] = W[(size_t)(k0 + kk) * N + n0 + (lane & 31)]; }
    LDS_WAIT(); CFENCE();
    const int c = lane & 7;
#pragma unroll
    for (int j = 0; j < 4; ++j) { const int n = (lane >> 3) + 8 * j; const LAS float* s = scr + (8 * c) * 33 + n;
        v4u o; o.x = pk2(s[0 * 33], s[1 * 33]); o.y = pk2(s[2 * 33], s[3 * 33]); o.z = pk2(s[4 * 33], s[5 * 33]); o.w = pk2(s[6 * 33], s[7 * 33]);
        *(GAS v4u*)(WT + (size_t)(dst_row0 + n) * K + k0 + 8 * c) = o; }
    LDS_WAIT(); CFENCE();
}
__device__ __forceinline__ void rms_row_to_bf16(const float* xrow, const float* g, bf16* orow, int lane) {
    const GAS f32x4* xr = (const GAS f32x4*)xrow + lane; const GAS f32x4* gr = (const GAS f32x4*)g + lane;
    f32x4 v[4]; float s = 0.f;
#pragma unroll
    for (int j = 0; j < 4; ++j) { v[j] = xr[64 * j]; s += (v[j].x * v[j].x + v[j].y * v[j].y) + (v[j].z * v[j].z + v[j].w * v[j].w); }
    const float rstd = 1.0f / sqrtf(wave_sum(s) * (1.f / D) + EPS);
    GAS v2u* o8 = (GAS v2u*)orow + lane;
#pragma unroll
    for (int j = 0; j < 4; ++j) { const f32x4 gg = gr[64 * j]; v2u w; w.x = pk2(v[j].x * rstd * gg.x, v[j].y * rstd * gg.y); w.y = pk2(v[j].z * rstd * gg.z, v[j].w * rstd * gg.w); o8[64 * j] = w; }
}
__device__ __forceinline__ void p0_prologue(LAS unsigned char* lds, const Args& a, int gw, int NGW, int wave, int lane) {
    unsigned char* ws = a.ws;
    LAS float* scr = (LAS float*)(lds + wave * 16384);
    constexpr int I_IN = 16 * 64, I_KV = 16 * 64, I_SQ = 16 * 32, I_G = 16 * 88, I_DN = 44 * 32, I_L = 32;
    constexpr int NITEMS = I_IN + I_KV + 3 * I_SQ + 2 * I_G + I_DN + I_L;
    for (int it = gw; it < NITEMS; it += NGW) {
        int r = it;
        if (r < I_IN) { p0_transpose_item(a.in[2], D, NIN, (bf16*)(ws + WS_WIN), 32 * (r % 64), scr, 64 * (r / 64), 32 * (r % 64), lane); continue; } r -= I_IN;
        if (r < I_KV) { p0_transpose_item(a.in[18], D, 2048, (bf16*)(ws + WS_WKV), 32 * (r % 64), scr, 64 * (r / 64), 32 * (r % 64), lane); continue; } r -= I_KV;
        if (r < I_SQ) { p0_transpose_item(a.in[16], D, D, (bf16*)(ws + WS_WOUT), 32 * (r % 32), scr, 64 * (r / 32), 32 * (r % 32), lane); continue; } r -= I_SQ;
        if (r < I_SQ) { p0_transpose_item(a.in[17], D, D, (bf16*)(ws + WS_WQ), 32 * (r % 32), scr, 64 * (r / 32), 32 * (r % 32), lane); continue; } r -= I_SQ;
        if (r < I_SQ) { p0_transpose_item(a.in[19], D, D, (bf16*)(ws + WS_WO), 32 * (r % 32), scr, 64 * (r / 32), 32 * (r % 32), lane); continue; } r -= I_SQ;
        if (r < 2 * I_G) { const int up = r >= I_G; if (up) r -= I_G; const int n0 = 32 * (r % 88);
            p0_transpose_item(up ? a.in[21] : a.in[20], D, DFF, (bf16*)(ws + WS_WGU), 256 * (n0 / 128) + (n0 % 128) + 128 * up, scr, 64 * (r / 88), n0, lane); continue; } r -= 2 * I_G;
        if (r < I_DN) { p0_transpose_item(a.in[22], DFF, D, (bf16*)(ws + WS_WDN), 32 * (r % 32), scr, 64 * (r / 32), 32 * (r % 32), lane); continue; } r -= I_DN;
        { const int mat = r >> 4, hh = (r >> 1) & 7, nb = r & 1;
          p0_transpose_item((mat ? a.in[11] : a.in[9]) + hh * 4096, 64, 64, (bf16*)(ws + WS_LRUW) + (mat * 8 + hh) * 4096, 32 * nb, scr, 0, 32 * nb, lane); }
    }
    for (int m = gw; m < M; m += NGW) rms_row_to_bf16(a.in[0] + (size_t)m * D, a.in[23], (bf16*)(ws + WS_XN) + (size_t)m * D, lane);
    for (int m = gw; m < 2 * NMEM; m += NGW) rms_row_to_bf16(a.in[1] + (size_t)m * D, a.in[26], (bf16*)(ws + WS_MEMN) + (size_t)m * D, lane);
}
template <bool LAST>
__device__ __forceinline__ void row_pass(const float* hin, const bf16* Y, const float* rowss, const float* gpost, const float* gpre, float* hout, bf16* XN, int gw, int NGW, int lane) {
    for (int row = gw; row < M; row += NGW) {
        const float rstd = 1.0f / sqrtf(rowss[row] * (1.f / D) + EPS);
        const GAS f32x4* hr = (const GAS f32x4*)(hin + (size_t)row * D) + lane; const GAS v2u* yr = (const GAS v2u*)(Y + (size_t)row * D) + lane;
        GAS f32x4* orow = (GAS f32x4*)(hout + (size_t)row * D) + lane;
        f32x4 v[4]; float s = 0.f;
#pragma unroll
        for (int j = 0; j < 4; ++j) { const f32x4 hv = hr[64 * j]; const v2u yw = yr[64 * j]; const f32x4 gg = ((const GAS f32x4*)gpost)[lane + 64 * j];
            v[j].x = hv.x + bflo(yw.x) * rstd * gg.x; v[j].y = hv.y + bfhi(yw.x) * rstd * gg.y; v[j].z = hv.z + bflo(yw.y) * rstd * gg.z; v[j].w = hv.w + bfhi(yw.y) * rstd * gg.w;
            s += (v[j].x * v[j].x + v[j].y * v[j].y) + (v[j].z * v[j].z + v[j].w * v[j].w); orow[64 * j] = v[j]; }
        if (!LAST) {
            const float r2 = 1.0f / sqrtf(wave_sum(s) * (1.f / D) + EPS);
            GAS v2u* o8 = (GAS v2u*)(XN + (size_t)row * D) + lane;
#pragma unroll
            for (int j = 0; j < 4; ++j) { const f32x4 gg = ((const GAS f32x4*)gpre)[lane + 64 * j]; v2u w; w.x = pk2(v[j].x * r2 * gg.x, v[j].y * r2 * gg.y); w.y = pk2(v[j].z * r2 * gg.z, v[j].w * r2 * gg.w); o8[64 * j] = w; }
        }
    }
}

__device__ __forceinline__ void gmlp_item(LAS unsigned char* lds, const Args& a, const bf16* Z, bf16* YCAT, int chunk, int wid, int lane) {
    constexpr int RS = 272;
    LAS float* stat = (LAS float*)lds;
    LAS unsigned char* vt = lds + 1024;
    const int r0 = chunk * 128, fr = lane & 15, fq = lane >> 4;
    const float* ln_g = a.in[3]; const float* ln_b = a.in[4]; const float* w_s = a.in[5]; const float* b_s = a.in[6]; const float* g_out = a.in[14];
    for (int i = 0; i < 16; ++i) {
        const int t = 16 * wid + i; float x[8];
        unpack8(*(const GAS v4u*)(Z + (size_t)(r0 + t) * NIN + 512 + 8 * lane), x);
        float s = 0.f;
#pragma unroll
        for (int e = 0; e < 8; ++e) s += x[e];
        const float mean = wave_sum(s) * (1.f / GWID); float d2 = 0.f;
#pragma unroll
        for (int e = 0; e < 8; ++e) { const float d = x[e] - mean; d2 += d * d; }
        const float rstd = 1.0f / sqrtf(wave_sum(d2) * (1.f / GWID) + EPS);
        if (lane == 0) { stat[2 * t] = mean; stat[2 * t + 1] = rstd; }
    }
    __syncthreads();
    v2u ypk[4][8]; float ss = 0.f;
    const int t = 16 * wid + fr; const size_t row = (size_t)(r0 + t);
#pragma unroll
    for (int h = 0; h < 4; ++h) {
        SBAR();
        f32x4 acc[8];
#pragma unroll
        for (int df = 0; df < 8; ++df) acc[df] = (f32x4){0.f, 0.f, 0.f, 0.f};
#pragma unroll
        for (int oo = 0; oo < 2; ++oo) {
            const int d0 = 8 * (2 * wid + oo), col = 512 + 128 * h + d0; float x0[8], x1[8], gg[8], bb[8];
            unpack8(*(const GAS v4u*)(Z + (size_t)(r0 + 2 * lane) * NIN + col), x0); unpack8(*(const GAS v4u*)(Z + (size_t)(r0 + 2 * lane + 1) * NIN + col), x1);
            const float m0 = stat[4 * lane], rs0 = stat[4 * lane + 1], m1 = stat[4 * lane + 2], rs1 = stat[4 * lane + 3];
            { const f32x4 g0 = *(const GAS f32x4*)(ln_g + 128 * h + d0), g1 = *(const GAS f32x4*)(ln_g + 128 * h + d0 + 4), b0 = *(const GAS f32x4*)(ln_b + 128 * h + d0), b1 = *(const GAS f32x4*)(ln_b + 128 * h + d0 + 4);
#pragma unroll
              for (int e = 0; e < 4; ++e) { gg[e] = g0[e]; gg[4 + e] = g1[e]; bb[e] = b0[e]; bb[4 + e] = b1[e]; } }
#pragma unroll
            for (int e = 0; e < 8; ++e) *(LAS unsigned*)(vt + (d0 + e) * RS + 4 * lane) = pk2((x0[e] - m0) * rs0 * gg[e] + bb[e], (x1[e] - m1) * rs1 * gg[e] + bb[e]);
        }
        __syncthreads();
#pragma unroll
        for (int ks = 0; ks < 4; ++ks) {
            if (32 * ks <= 16 * wid + 15) {
                const float* wp = w_s + (size_t)(h * 128 + t) * 128 + 32 * ks + 8 * fq; const int p0 = 32 * ks + 8 * fq;
                const f32x4 w0 = *(const GAS f32x4*)wp, w1 = *(const GAS f32x4*)(wp + 4); float wv[8];
#pragma unroll
                for (int e = 0; e < 4; ++e) { wv[e] = (p0 + e <= t) ? w0[e] : 0.f; wv[4 + e] = (p0 + 4 + e <= t) ? w1[e] : 0.f; }
                const bf16x8 wf = pack8(wv);
#pragma unroll
                for (int df = 0; df < 8; ++df) { const bf16x8 vf = *(const LAS bf16x8*)(vt + (16 * df + fr) * RS + (32 * ks + 8 * fq) * 2); acc[df] = MFMA16(vf, wf, acc[df]); }
            }
        }
        const float bs = b_s[h * 128 + t];
#pragma unroll
        for (int df = 0; df < 8; ++df) { const v2u uw = *(const GAS v2u*)(Z + row * NIN + 128 * h + 16 * df + 4 * fq);
            const float y0 = bflo(uw.x) * (acc[df][0] + bs), y1 = bfhi(uw.x) * (acc[df][1] + bs), y2 = bflo(uw.y) * (acc[df][2] + bs), y3 = bfhi(uw.y) * (acc[df][3] + bs);
            ss += (y0 * y0 + y1 * y1) + (y2 * y2 + y3 * y3); ypk[h][df].x = pk2(y0, y1); ypk[h][df].y = pk2(y2, y3); }
        __syncthreads();
    }
    ss += __shfl_xor(ss, 16); ss += __shfl_xor(ss, 32);
    const float rstd = 1.0f / sqrtf(ss * (1.f / GWID) + EPS);
#pragma unroll
    for (int h = 0; h < 4; ++h)
#pragma unroll
        for (int df = 0; df < 8; ++df) { if ((df & 3) == 0) SBAR(); const int c = 128 * h + 16 * df + 4 * fq; const f32x4 g = *(const GAS f32x4*)(g_out + c); const v2u y = ypk[h][df];
            v2u w; w.x = pk2(bflo(y.x) * rstd * g[0], bfhi(y.x) * rstd * g[1]); w.y = pk2(bflo(y.y) * rstd * g[2], bfhi(y.y) * rstd * g[3]); *(GAS v2u*)(YCAT + row * D + c) = w; }
}

template <int PASS>
__device__ __forceinline__ void lru_item(LAS unsigned char* lds, const Args& a, const bf16* Z, const bf16* LRUW, float* AGG, bf16* YCAT, int item, int wid, int lane) {
    constexpr int RS = 144, TILE = 9728;
    const int b = item >> 7, j = item & 127, h = wid, fr = lane & 15, fq = lane >> 4;
    const size_t tok0 = (size_t)b * SEQ + 64 * j;
    LAS unsigned char* tile = lds + wid * TILE;
    LAS float* part = (LAS float*)(lds + 8 * TILE);
    const float* conv_w = a.in[7]; const float* conv_b = a.in[8]; const float* b_a = a.in[10]; const float* b_x = a.in[12]; const float* lam = a.in[13]; const float* g_lru = a.in[15];
#pragma unroll
    for (int it = 0; it < 9; ++it) { const int q = lane + 64 * it, rr = q >> 3, ch = q & 7;
        if (rr < 67) { v4u v = (v4u){0u, 0u, 0u, 0u}; if (j > 0 || rr >= 3) v = *(const GAS v4u*)(Z + (tok0 + rr - 3) * NIN + 1024 + 64 * h + 8 * ch); *(LAS v4u*)(tile + rr * RS + 16 * ch) = v; } }
    CFENCE();
    bf16x8 xf[4][2];
#pragma unroll
    for (int ks = 0; ks < 2; ++ks) { const int c0 = 64 * h + 32 * ks + 8 * fq; float cw[4][8], cb[8];
#pragma unroll
        for (int k = 0; k < 4; ++k) { const f32x4 w0 = *(const GAS f32x4*)(conv_w + k * GWID + c0), w1 = *(const GAS f32x4*)(conv_w + k * GWID + c0 + 4);
#pragma unroll
            for (int e = 0; e < 4; ++e) { cw[k][e] = w0[e]; cw[k][4 + e] = w1[e]; } }
        { const f32x4 w0 = *(const GAS f32x4*)(conv_b + c0), w1 = *(const GAS f32x4*)(conv_b + c0 + 4);
#pragma unroll
          for (int e = 0; e < 4; ++e) { cb[e] = w0[e]; cb[4 + e] = w1[e]; } }
#pragma unroll
        for (int tf = 0; tf < 4; ++tf) { SBAR(); float xc[8];
#pragma unroll
            for (int e = 0; e < 8; ++e) xc[e] = cb[e];
#pragma unroll
            for (int k = 0; k < 4; ++k) { float xv[8]; unpack8(*(const LAS v4u*)(tile + (16 * tf + fr + k) * RS + (32 * ks + 8 * fq) * 2), xv);
#pragma unroll
                for (int e = 0; e < 8; ++e) xc[e] += cw[k][e] * xv[e]; }
            xf[tf][ks] = pack8(xc); } }
    SBAR();
    float hfold = 0.f;
    if (PASS == 1) {
#pragma unroll
        for (int it = 0; it < 8; ++it) { const int q = lane + 64 * it, rr = q >> 3, ch = q & 7; *(LAS v4u*)(tile + rr * RS + 16 * ch) = *(const GAS v4u*)(Z + (tok0 + rr) * NIN + 1536 + 64 * h + 8 * ch); }
        CFENCE();
        const int c = 64 * h + lane; const float* ag = AGG + (size_t)b * 128 * 2 * GWID + c;
#pragma unroll 4
        for (int q = 0; q < j; ++q) { const float A = ag[(size_t)(2 * q) * GWID], Bv = ag[(size_t)(2 * q + 1) * GWID]; hfold = A * hfold + Bv; } }
    float ssq[4][4];
#pragma unroll
    for (int tf = 0; tf < 4; ++tf)
#pragma unroll
        for (int i = 0; i < 4; ++i) ssq[tf][i] = 0.f;
#pragma unroll
    for (int jf = 0; jf < 4; ++jf) {
        SBAR();
        const int cl = 16 * jf + fr, c = 64 * h + cl;
        bf16x8 wa[2], wx[2], sel;
#pragma unroll
        for (int ks = 0; ks < 2; ++ks) { wa[ks] = *(const GAS bf16x8*)(LRUW + (size_t)((0 * 8 + h) * 64 + cl) * 64 + 32 * ks + 8 * fq); wx[ks] = *(const GAS bf16x8*)(LRUW + (size_t)((1 * 8 + h) * 64 + cl) * 64 + 32 * ks + 8 * fq); }
        { const int kp = 16 * (jf & 1) + fr;
#pragma unroll
          for (int e = 0; e < 8; ++e) sel[e] = (short)((fq == (kp >> 3) && e == (kp & 7)) ? 0x3f80 : 0); }
        const float ba = b_a[c], bx = b_x[c], sp = log1pf(expf(-lam[c]));
        float hc = (PASS == 1) ? __shfl(hfold, cl) : 0.f, Ac = 1.f, Bc = 0.f;
#pragma unroll
        for (int tf = 0; tf < 4; ++tf) {
            SBAR();
            const f32x4 z4 = (f32x4){0.f, 0.f, 0.f, 0.f};
            f32x4 aR = MFMA16(xf[tf][0], wa[0], z4), aI = MFMA16(xf[tf][0], wx[0], z4); aR = MFMA16(xf[tf][1], wa[1], aR); aI = MFMA16(xf[tf][1], wx[1], aI);
            const f32x4 xc4 = MFMA16(xf[tf][jf >> 1], sel, z4);
            float av[4], bv[4];
#pragma unroll
            for (int i = 0; i < 4; ++i) { const float rg = pg8::sigmoid1(aR[i] + ba), ig = pg8::sigmoid1(aI[i] + bx), la = -8.0f * rg * sp;
                av[i] = __expf(la); bv[i] = sqrtf(-expm1f(2.0f * la)) * (ig * xc4[i]); }
            float Al = av[0], Bl = bv[0];
#pragma unroll
            for (int i = 1; i < 4; ++i) { Bl = av[i] * Bl + bv[i]; Al *= av[i]; }
            { const float A1 = __shfl_up(Al, 16), B1 = __shfl_up(Bl, 16); if (fq >= 1) { Bl = Al * B1 + Bl; Al = A1 * Al; } }
            { const float A2 = __shfl_up(Al, 32), B2 = __shfl_up(Bl, 32); if (fq >= 2) { Bl = Al * B2 + Bl; Al = A2 * Al; } }
            const float At = __shfl(Al, fr + 48), Bt = __shfl(Bl, fr + 48);
            if (PASS == 0) { Bc = At * Bc + Bt; Ac = Ac * At; }
            else { float Ae = __shfl_up(Al, 16), Be = __shfl_up(Bl, 16); if (fq == 0) { Ae = 1.f; Be = 0.f; }
                float hh = Ae * hc + Be;
#pragma unroll
                for (int i = 0; i < 4; ++i) { hh = av[i] * hh + bv[i];
                    LAS unsigned short* gp = (LAS unsigned short*)(tile + (16 * tf + 4 * fq + i) * RS + cl * 2);
                    const float y = bf1(*gp) * hh; ssq[tf][i] += y * y; *gp = (unsigned short)(pk2(y, 0.f) & 0xffffu); }
                hc = At * hc + Bt; }
        }
        if (PASS == 0 && fq == 0) { float* ag = AGG + ((size_t)(b * 128 + j) * 2) * GWID + c; ag[0] = Ac; ag[GWID] = Bc; }
    }
    if (PASS == 1) {
        SBAR();
#pragma unroll
        for (int tf = 0; tf < 4; ++tf)
#pragma unroll
            for (int i = 0; i < 4; ++i) { float s = ssq[tf][i]; s += __shfl_xor(s, 1); s += __shfl_xor(s, 2); s += __shfl_xor(s, 4); s += __shfl_xor(s, 8);
                if (fr == 0) part[(16 * tf + 4 * fq + i) * 8 + wid] = s; }
        __syncthreads();
        float rstd;
        { const f32x4 p0 = *(const LAS f32x4*)(part + lane * 8), p1 = *(const LAS f32x4*)(part + lane * 8 + 4);
          rstd = 1.0f / sqrtf(((p0[0] + p0[1]) + (p0[2] + p0[3]) + (p1[0] + p1[1]) + (p1[2] + p1[3])) * (1.f / GWID) + EPS); }
        float gl[8];
        { const int c0 = 64 * h + 8 * (lane & 7); const f32x4 g0 = *(const GAS f32x4*)(g_lru + c0), g1 = *(const GAS f32x4*)(g_lru + c0 + 4);
#pragma unroll
          for (int e = 0; e < 4; ++e) { gl[e] = g0[e]; gl[4 + e] = g1[e]; } }
#pragma unroll
        for (int it = 0; it < 8; ++it) { const int q = lane + 64 * it, rr = q >> 3, ch = q & 7; const float rs = __shfl(rstd, rr); float y[8];
            unpack8(*(const LAS v4u*)(tile + rr * RS + 16 * ch), y);
#pragma unroll
            for (int e = 0; e < 8; ++e) y[e] = y[e] * rs * gl[e];
            *(GAS bf16x8*)(YCAT + (tok0 + rr) * D + 512 + 64 * h + 8 * ch) = pack8(y); }
        __syncthreads();
    }
}

__device__ __forceinline__ void attn_item(LAS unsigned char* lds, const bf16* KB, const bf16* VT, const bf16* QO, bf16* OO, int item, int tid, int wid, int lane) {
    const int tile = item & 31, h = (item >> 5) & 3, b = item >> 7, fr = lane & 15, fq = lane >> 4;
#pragma unroll 4
    for (int it = 0; it < 16; ++it) { const int q = tid + 512 * it, m = q >> 5, c = q & 31;
        *(LAS v4u*)(lds + m * 512 + ((c ^ (m & 15)) << 4)) = *(const GAS v4u*)(KB + (size_t)(b * NMEM + m) * D + h * 256 + 8 * c); }
    __syncthreads();
    bf16x8 pf[2][8]; float inv[2];
#pragma unroll
    for (int s = 0; s < 2; ++s) {
        const size_t row = (size_t)b * SEQ + tile * 256 + 128 * s + 16 * wid + fr;
        f32x4 S[16];
#pragma unroll
        for (int mf = 0; mf < 16; ++mf) S[mf] = (f32x4){0.f, 0.f, 0.f, 0.f};
#pragma unroll
        for (int ks = 0; ks < 8; ++ks) { const bf16x8 qf = *(const GAS bf16x8*)(QO + row * D + h * 256 + 32 * ks + 8 * fq);
#pragma unroll
            for (int mf = 0; mf < 16; ++mf) { const bf16x8 kf = *(const LAS bf16x8*)(lds + (16 * mf + fr) * 512 + (((4 * ks + fq) ^ fr) << 4)); S[mf] = MFMA16(kf, qf, S[mf]); } }
        float mx = S[0][0];
#pragma unroll
        for (int mf = 0; mf < 16; ++mf)
#pragma unroll
            for (int e = 0; e < 4; ++e) mx = fmaxf(mx, S[mf][e]);
        mx = fmaxf(mx, __shfl_xor(mx, 16)); mx = fmaxf(mx, __shfl_xor(mx, 32));
        float sum = 0.f;
#pragma unroll
        for (int mf = 0; mf < 16; ++mf)
#pragma unroll
            for (int e = 0; e < 4; ++e) { const float p = __builtin_amdgcn_exp2f((S[mf][e] - mx) * 1.4426950408889634f); S[mf][e] = p; sum += p; }
        sum += __shfl_xor(sum, 16); sum += __shfl_xor(sum, 32); inv[s] = 1.0f / sum;
#pragma unroll
        for (int ks = 0; ks < 8; ++ks) { v4u w; w.x = pk2(S[2 * ks][0], S[2 * ks][1]); w.y = pk2(S[2 * ks][2], S[2 * ks][3]); w.z = pk2(S[2 * ks + 1][0], S[2 * ks + 1][1]); w.w = pk2(S[2 * ks + 1][2], S[2 * ks + 1][3]);
            pf[s][ks] = __builtin_bit_cast(bf16x8, w); }
    }
    __syncthreads();
#pragma unroll 4
    for (int it = 0; it < 16; ++it) { const int q = tid + 512 * it, d = q >> 5, c = q & 31;
        *(LAS v4u*)(lds + d * 512 + ((c ^ (d & 15)) << 4)) = *(const GAS v4u*)(VT + ((size_t)b * D + h * 256 + d) * NMEM + 8 * c); }
    __syncthreads();
#pragma unroll
    for (int s = 0; s < 2; ++s) {
        const size_t row = (size_t)b * SEQ + tile * 256 + 128 * s + 16 * wid + fr;
        f32x4 O[16];
#pragma unroll
        for (int df = 0; df < 16; ++df) O[df] = (f32x4){0.f, 0.f, 0.f, 0.f};
#pragma unroll
        for (int ks = 0; ks < 8; ++ks)
#pragma unroll
            for (int df = 0; df < 16; ++df) { const bf16x8 vf = *(const LAS bf16x8*)(lds + (16 * df + fr) * 512 + (((4 * ks + fq) ^ fr) << 4)); O[df] = MFMA16(vf, pf[s][ks], O[df]); }
#pragma unroll
        for (int df = 0; df < 16; ++df) { v2u w; w.x = pk2(O[df][0] * inv[s], O[df][1] * inv[s]); w.y = pk2(O[df][2] * inv[s], O[df][3] * inv[s]); *(GAS v2u*)(OO + row * D + h * 256 + 16 * df + 4 * fq) = w; }
    }
    __syncthreads();
}

#ifndef R0
#define R0 1
#endif
#ifndef R2
#define R2 1
#endif
#ifndef R3
#define R3 1
#endif
#ifndef R7
#define R7 1
#endif
#ifndef RB
#define RB 0
#endif
#define REPEAT(n) for (int rep_ = 0; rep_ < (n); ++rep_)
__global__ void __launch_bounds__(NWAVES * 64, 2) hybrid_fwd(Args args) {
    extern __shared__ __attribute__((aligned(16))) unsigned char lds_raw[];
    LAS unsigned char* lds = (LAS unsigned char*)lds_raw;
    volatile LAS unsigned* MISC = (volatile LAS unsigned*)(lds + MISC_OFF);
    const int G = gridDim.x, bx = blockIdx.x, NGW = G * NWAVES;
    unsigned char* ws = args.ws;
    unsigned* ctl = (unsigned*)(ws + WS_CTL);
    float* rowss = (float*)(ctl + CW_ROWSS);
    bf16* XN = (bf16*)(ws + WS_XN); bf16* Z = (bf16*)(ws + WS_Z); bf16* YCAT = (bf16*)(ws + WS_YCAT); bf16* Y = (bf16*)(ws + WS_Y); bf16* QO = (bf16*)(ws + WS_QO); bf16* ACT = (bf16*)(ws + WS_ACT);
    bf16* MEMN = (bf16*)(ws + WS_MEMN); bf16* KB = (bf16*)(ws + WS_KB); bf16* VT = (bf16*)(ws + WS_VT); float* AGG = (float*)(ws + WS_AGG); bf16* LRUW = (bf16*)(ws + WS_LRUW);
    for (int u = threadIdx.x; u < (LDS_BYTES - LDSCTL_OFF) / 4; u += NWAVES * 64) ((LAS unsigned*)(lds + LDSCTL_OFF))[u] = 0u;
    __syncthreads();
    XcdBarrier bar = xcd_barrier_post(ctl + CW_BAR, MISC + 8);
#define GRID_BAR() xcd_barrier(bar)
#define FRESH() int tid = threadIdx.x; asm volatile("" : "+v"(tid)); const int lane = tid & 63, wave = __builtin_amdgcn_readfirstlane(tid >> 6), gw = bx * NWAVES + wave; (void)lane; (void)gw

    REPEAT(R0) { { FRESH(); p0_prologue(lds, args, gw, NGW, wave, lane); }
    GRID_BAR(); }
    REPEAT(RB) GRID_BAR();
    { pg8::Gemm g{XN, (const bf16*)(ws + WS_WIN), M, NIN, D}; pg8::StaticOrder S; S.init(M, NIN, G, bx); pg8::EpiBf E{Z, NIN, 0xCFu, 1.0f};
      pg8::gemm_phase<pg8::EpiBf, pg8::StaticOrder, true, true>(lds, g, S, E); }
    GRID_BAR();
    REPEAT(R2) {
    { pg8::Gemm g{MEMN, (const bf16*)(ws + WS_WKV), 2 * NMEM, 2048, D}; pg8::StaticOrder S; S.init(2 * NMEM, 2048, G, bx); pg8::EpiKV E{KB, VT};
      pg8::gemm_phase<pg8::EpiKV, pg8::StaticOrder, true, true>(lds, g, S, E); }
    __syncthreads();
    for (int c = (bx + G - (16 % G)) % G; c < M / 128; c += G) { FRESH(); gmlp_item(lds, args, Z, YCAT, c, wave, lane); __syncthreads(); }
    for (int it = (bx + G - (144 % G)) % G; it < M / 64; it += G) { FRESH(); lru_item<0>(lds, args, Z, LRUW, AGG, YCAT, it, wave, lane); }
    GRID_BAR(); }
    REPEAT(R3) { for (int it = bx; it < M / 64; it += G) { FRESH(); lru_item<1>(lds, args, Z, LRUW, AGG, YCAT, it, wave, lane); }
    GRID_BAR(); }
    { pg8::Gemm g{YCAT, (const bf16*)(ws + WS_WOUT), M, D, D}; pg8::StaticOrder S; S.init(M, D, G, bx); pg8::EpiYss E{Y, D, rowss};
      pg8::gemm_phase<pg8::EpiYss, pg8::StaticOrder, true, true>(lds, g, S, E); }
    GRID_BAR();
    { FRESH(); row_pass<false>(args.in[0], Y, rowss, args.in[24], args.in[25], args.out, XN, gw, NGW, lane); }
    GRID_BAR();
    { pg8::Gemm g{XN, (const bf16*)(ws + WS_WQ), M, D, D}; pg8::StaticOrder S; S.init(M, D, G, bx); pg8::EpiBf E{QO, D, 0u, 0.0625f};
      pg8::gemm_phase<pg8::EpiBf, pg8::StaticOrder, true, true>(lds, g, S, E); }
    GRID_BAR();
    REPEAT(R7) { for (int it = bx; it < 256; it += G) { FRESH(); attn_item(lds, KB, VT, QO, YCAT, it, tid, wave, lane); }
    GRID_BAR(); }
    { pg8::Gemm g{YCAT, (const bf16*)(ws + WS_WO), M, D, D}; pg8::StaticOrder S; S.init(M, D, G, bx); pg8::EpiYss E{Y, D, rowss + M};
      pg8::gemm_phase<pg8::EpiYss, pg8::StaticOrder, true, true>(lds, g, S, E); }
    GRID_BAR();
    { FRESH(); row_pass<false>(args.out, Y, rowss + M, args.in[27], args.in[28], args.out, XN, gw, NGW, lane); }
    GRID_BAR();
    { pg8::Gemm g{XN, (const bf16*)(ws + WS_WGU), M, 2 * DFF, D}; pg8::StaticOrder S; S.init(M, 2 * DFF, G, bx); pg8::EpiGU E{ACT, DFF};
      pg8::gemm_phase<pg8::EpiGU, pg8::StaticOrder, true, true>(lds, g, S, E); }
    GRID_BAR();
    { pg8::Gemm g{ACT, (const bf16*)(ws + WS_WDN), M, D, DFF}; pg8::StaticOrder S; S.init(M, D, G, bx); pg8::EpiYss E{Y, D, rowss + 2 * M};
      pg8::gemm_phase<pg8::EpiYss, pg8::StaticOrder, true, true>(lds, g, S, E); }
    GRID_BAR();
    { FRESH(); row_pass<true>(args.out, Y, rowss + 2 * M, args.in[29], nullptr, args.out, nullptr, gw, NGW, lane); }
}

extern "C" void kernel_launch(void* const* d_in, const int* in_sizes, int n_in, void* d_out, int out_size, void* d_ws, size_t ws_size, hipStream_t stream) {
    static int grid = 0;
    if (grid == 0) {
        if (n_in != 30 || in_sizes[0] != M * D || out_size != M * D || ws_size < WS_END) { fprintf(stderr, "kernel_launch: unexpected problem shape (n_in %d, in0 %d, out %d, ws %zu)\n", n_in, n_in > 0 ? in_sizes[0] : -1, out_size, ws_size); grid = -1; return; }
        int dev = 0, cus = 0, per_cu = 0;
        if (hipGetDevice(&dev) != hipSuccess || hipDeviceGetAttribute(&cus, hipDeviceAttributeMultiprocessorCount, dev) != hipSuccess) { grid = -1; return; }
        if (hipFuncSetAttribute((const void*)hybrid_fwd, hipFuncAttributeMaxDynamicSharedMemorySize, LDS_BYTES) != hipSuccess) { fprintf(stderr, "kernel_launch: hipFuncSetAttribute failed\n"); grid = -1; return; }
        if (hipOccupancyMaxActiveBlocksPerMultiprocessor(&per_cu, (const void*)hybrid_fwd, NWAVES * 64, LDS_BYTES) != hipSuccess || per_cu < 1) { fprintf(stderr, "kernel_launch: occupancy query says %d blocks per CU\n", per_cu); grid = -1; return; }
        grid = cus;
    }
    if (grid < 0) return;
    (void)hipMemsetAsync((char*)d_ws + WS_CTL, 0, CTL_ZERO_BYTES, stream);
    Args a{};
    for (int i = 0; i < 30; ++i) a.in[i] = (const float*)d_in[i];
    a.out = (float*)d_out; a.ws = (unsigned char*)d_ws;
    void* kargs[] = {&a};
    hipError_t e = hipLaunchCooperativeKernel((const void*)hybrid_fwd, dim3(grid), dim3(NWAVES * 64), kargs, LDS_BYTES, stream);
    if (e != hipSuccess) fprintf(stderr, "kernel_launch: cooperative launch failed: %s (grid %d)\n", hipGetErrorString(e), grid);
}
```

```cpp
#include <hip/hip_runtime.h>
#include <cstdio>
#include <cstdint>
namespace pg8 {
#define PG8_LAS __attribute__((address_space(3)))
typedef unsigned short bf16_t;
typedef short bf16x8 __attribute__((ext_vector_type(8)));
typedef float f32x4 __attribute__((ext_vector_type(4)));
typedef unsigned u32x4 __attribute__((ext_vector_type(4)));
constexpr int BM = 256, BK = 64, HALF = 128, HTB = HALF * BK * 2  , STAGE_BYTES = 8 * HTB, NXCD = 8, WGM = 8;

__host__ __device__ __forceinline__ int lds_byte(int r, int c) { const int st = (r >> 4) * 2 + (c >> 5), rr = r & 15, cc = c & 31, ob = rr * 64 + cc * 2; return st * 1024 + (ob ^ (((ob >> 9) & 1) << 5)); }
__host__ __device__ __forceinline__ void stage_rc(int b, int& R, int& C) { const int st = b / 1024, sb = b % 1024, swz = sb ^ (((sb >> 9) & 1) << 5); R = (st >> 1) * 16 + swz / 64; C = (st & 1) * 32 + (swz % 64) / 2; }
__host__ __device__ __forceinline__ int perm32(int rho) { const int n = rho >> 4, i = rho & 15; return 8 * (i >> 2) + 4 * n + (i & 3); }

struct Unit { int pm, pn; };
struct Gemm { const bf16_t* A; const bf16_t* Bt; int M, N, K; };

struct StaticOrder {
    int nM, nN, nwg, G, c;
    __host__ __device__ void init(int M, int N, int G_, int c_) { nM = M / BM; nN = N / BM; nwg = nM * nN; G = G_; c = c_; }
    __host__ __device__ bool next(int i, Unit& u) const {
        const long L = (long)i * G + c; if (L >= nwg) return false;
        int wgid = (int)L; { const int q = nwg / NXCD, r = nwg % NXCD, xcd = wgid % NXCD, off = wgid / NXCD; wgid = (xcd < r ? xcd * (q + 1) : r * (q + 1) + (xcd - r) * q) + off; }
        const int nig = WGM * nN, gid = wgid / nig, fm = gid * WGM, gsz = (nM - fm) < WGM ? (nM - fm) : WGM;
        u.pm = fm + ((wgid % nig) % gsz); u.pn = (wgid % nig) / gsz; return true;
    }
    __device__ __forceinline__ void a_ready(const Unit&) const {}
    __device__ __forceinline__ void done(const Unit&) const {}
};

__device__ __forceinline__ unsigned cvt_pk_bf16(float lo, float hi) { unsigned r; asm volatile("v_cvt_pk_bf16_f32 %0, %1, %2" : "=v"(r) : "v"(lo), "v"(hi)); return r; }
typedef float f32x2 __attribute__((ext_vector_type(2)));
__device__ __forceinline__ f32x2 gelu_pk(f32x2 v) {
    const f32x2 av = __builtin_elementwise_abs(v), d = av * 0.2316418882f + 1.0f;
    f32x2 t; t.x = __builtin_amdgcn_rcpf(d.x); t.y = __builtin_amdgcn_rcpf(d.y);
    f32x2 q = t * 0.5307027145f + (-0.7265760135f); q = q * t + 0.7107068705f; q = q * t + (-0.142248368f); q = q * t + 0.127414796f; q = q * t;
    const f32x2 s = (v * v) * (-0.72134752044f);
    f32x2 e; e.x = __builtin_amdgcn_exp2f(s.x); e.y = __builtin_amdgcn_exp2f(s.y);
    const f32x2 m = v * (q * e), r = v - m;
    f32x2 o; o.x = v.x < 0.f ? m.x : r.x; o.y = v.y < 0.f ? m.y : r.y; return o;
}
__device__ __forceinline__ float gelu_tanh1(float x) {
    const float z = x * (1.0f + 0.044715f * x * x) * (-1.5957691216057308f * 1.4426950408889634f);
    return x * __builtin_amdgcn_rcpf(1.0f + __builtin_amdgcn_exp2f(z));
}
__device__ __forceinline__ float sigmoid1(float x) { return __builtin_amdgcn_rcpf(1.0f + __builtin_amdgcn_exp2f(x * -1.4426950408889634f)); }
struct EpiBf {
    static constexpr bool PERM = true, AFTER_DRAIN = false;
    bf16_t* O; int ldc; unsigned gelu_mask; float scale;
    __device__ __forceinline__ void operator()(const f32x4 (&acc)[2][2][4][2], const Unit& u, int wr, int wc, int fr, int fq) const {
        const int row0 = u.pm * BM + wr * 64 + fr, col0 = u.pn * BM + wc * 32 + 8 * fq;
        const bool act = (gelu_mask >> u.pn) & 1u;
#pragma unroll
        for (int ai = 0; ai < 2; ++ai)
#pragma unroll
            for (int m = 0; m < 4; ++m) { bf16_t* rowp = O + (size_t)(row0 + ai * HALF + m * 16) * ldc + col0;
#pragma unroll
                for (int bj = 0; bj < 2; ++bj) { f32x4 v0 = acc[ai][bj][m][0], v1 = acc[ai][bj][m][1];
                    if (act) {
#pragma unroll
                        for (int e = 0; e < 4; ++e) { v0[e] = gelu_tanh1(v0[e]); v1[e] = gelu_tanh1(v1[e]); } }
                    v0 = v0 * scale; v1 = v1 * scale; u32x4 w; w.x = cvt_pk_bf16(v0[0], v0[1]); w.y = cvt_pk_bf16(v0[2], v0[3]); w.z = cvt_pk_bf16(v1[0], v1[1]); w.w = cvt_pk_bf16(v1[2], v1[3]);
                    *(u32x4*)(rowp + bj * HALF) = w; } }
    }
};
struct EpiYss {
    static constexpr bool PERM = true, AFTER_DRAIN = false;
    bf16_t* O; int ldc; float* rowss;
    __device__ __forceinline__ void operator()(const f32x4 (&acc)[2][2][4][2], const Unit& u, int wr, int wc, int fr, int fq) const {
        const int row0 = u.pm * BM + wr * 64 + fr, col0 = u.pn * BM + wc * 32 + 8 * fq;
#pragma unroll
        for (int ai = 0; ai < 2; ++ai)
#pragma unroll
            for (int m = 0; m < 4; ++m) { const int row = row0 + ai * HALF + m * 16; bf16_t* rowp = O + (size_t)row * ldc + col0; float ss = 0.f;
#pragma unroll
                for (int bj = 0; bj < 2; ++bj) { const f32x4 v0 = acc[ai][bj][m][0], v1 = acc[ai][bj][m][1];
                    ss += (v0[0] * v0[0] + v0[1] * v0[1]) + (v0[2] * v0[2] + v0[3] * v0[3]) + (v1[0] * v1[0] + v1[1] * v1[1]) + (v1[2] * v1[2] + v1[3] * v1[3]);
                    u32x4 w; w.x = cvt_pk_bf16(v0[0], v0[1]); w.y = cvt_pk_bf16(v0[2], v0[3]); w.z = cvt_pk_bf16(v1[0], v1[1]); w.w = cvt_pk_bf16(v1[2], v1[3]);
                    *(u32x4*)(rowp + bj * HALF) = w; }
                ss += __shfl_xor(ss, 16); ss += __shfl_xor(ss, 32);
                if (fq == 0) __hip_atomic_fetch_add(rowss + row, ss, __ATOMIC_RELAXED, __HIP_MEMORY_SCOPE_AGENT); }
    }
};
struct EpiGU {
    static constexpr bool PERM = true, AFTER_DRAIN = false;
    bf16_t* O; int ldc;
    __device__ __forceinline__ void operator()(const f32x4 (&acc)[2][2][4][2], const Unit& u, int wr, int wc, int fr, int fq) const {
        const int row0 = u.pm * BM + wr * 64 + fr, col0 = u.pn * HALF + wc * 32 + 8 * fq;
#pragma unroll
        for (int ai = 0; ai < 2; ++ai)
#pragma unroll
            for (int m = 0; m < 4; ++m) { bf16_t* rowp = O + (size_t)(row0 + ai * HALF + m * 16) * ldc + col0;
                f32x4 r0, r1;
#pragma unroll
                for (int e = 0; e < 4; ++e) { const float g0 = acc[ai][0][m][0][e], g1 = acc[ai][0][m][1][e];
                    r0[e] = g0 * sigmoid1(g0) * acc[ai][1][m][0][e]; r1[e] = g1 * sigmoid1(g1) * acc[ai][1][m][1][e]; }
                u32x4 w; w.x = cvt_pk_bf16(r0[0], r0[1]); w.y = cvt_pk_bf16(r0[2], r0[3]); w.z = cvt_pk_bf16(r1[0], r1[1]); w.w = cvt_pk_bf16(r1[2], r1[3]);
                *(u32x4*)rowp = w; }
    }
};
struct EpiKV {
    static constexpr bool PERM = true, AFTER_DRAIN = false;
    bf16_t* Kb; bf16_t* VT;
    __device__ __forceinline__ void operator()(const f32x4 (&acc)[2][2][4][2], const Unit& u, int wr, int wc, int fr, int fq) const {
        const int row0 = u.pm * BM + wr * 64 + fr, col0 = u.pn * BM + wc * 32 + 8 * fq;
        if (u.pn < 4) {
#pragma unroll
            for (int ai = 0; ai < 2; ++ai)
#pragma unroll
                for (int m = 0; m < 4; ++m) { bf16_t* rowp = Kb + (size_t)(row0 + ai * HALF + m * 16) * 1024 + col0;
#pragma unroll
                    for (int bj = 0; bj < 2; ++bj) { const f32x4 v0 = acc[ai][bj][m][0], v1 = acc[ai][bj][m][1];
                        u32x4 w; w.x = cvt_pk_bf16(v0[0], v0[1]); w.y = cvt_pk_bf16(v0[2], v0[3]); w.z = cvt_pk_bf16(v1[0], v1[1]); w.w = cvt_pk_bf16(v1[2], v1[3]);
                        *(u32x4*)(rowp + bj * HALF) = w; } }
        } else {
#pragma unroll
            for (int ai = 0; ai < 2; ++ai)
#pragma unroll
                for (int m = 0; m < 4; ++m) { const int mm = wr * 64 + ai * HALF + m * 16 + fr;
                    const int pos = (mm & ~31) + 8 * ((mm >> 2) & 3) + 4 * ((mm >> 4) & 1) + (mm & 3);
                    bf16_t* base = VT + (size_t)u.pm * 1024 * 256 + pos;
#pragma unroll
                    for (int bj = 0; bj < 2; ++bj)
#pragma unroll
                        for (int n = 0; n < 2; ++n)
#pragma unroll
                            for (int e = 0; e < 4; ++e) { const int hd = col0 - 1024 + bj * HALF + 4 * n + e;
                                base[(size_t)hd * 256] = (bf16_t)(cvt_pk_bf16(acc[ai][bj][m][n][e], 0.f) & 0xffffu); } }
        }
    }
};
template <class Epi, class Sched, bool ALIGN_EPI = false, bool SP2 = false>
__device__ __forceinline__ void gemm_phase(PG8_LAS unsigned char* lds, const Gemm g, const Sched& S, const Epi& E) {
    int tid_l = threadIdx.x; asm volatile("" : "+v"(tid_l));
    const int tid = tid_l, wid = __builtin_amdgcn_readfirstlane(tid >> 6), lane = tid & 63, wr = wid >> 2, wc = wid & 3, fr = lane & 15, fq = lane >> 4;
    const int K = g.K, nt = K / BK;
    unsigned voffA[2], voffB[2];
#pragma unroll
    for (int i = 0; i < 2; ++i) { int R, C; stage_rc(tid * 16 + i * 8192, R, C); const int Rb = Epi::PERM ? ((R & ~31) + perm32(R & 31)) : R;
        voffA[i] = (unsigned)(R * K + C) * 2u; voffB[i] = (unsigned)(Rb * K + C) * 2u; }
    const size_t kstep = (size_t)(BK * 2);
    const size_t hstep = (size_t)HALF * K * 2;
    const size_t tstep = 2 * hstep;
    const unsigned ldsw = (unsigned)wid * 1024u;
    const int aoff = lds_byte(wr * 64 + fr, fq * 8), boff = lds_byte(wc * 32 + fr, fq * 8);
#define PG8_SA(b, h) (((b) * 2 + (h)) * HTB)
#define PG8_SB(b, h) ((4 + (b) * 2 + (h)) * HTB)
#define PG8_STAGE(bufoff, gbase, voff) do { _Pragma("unroll") for (int _i = 0; _i < 2; ++_i) \
        __builtin_amdgcn_global_load_lds((const unsigned*)((const char*)(gbase) + (voff)[_i]), (PG8_LAS unsigned*)(lds + (bufoff) + ldsw + _i * 8192), 16, 0, 0); } while (0)
#define PG8_LDA(dst, b, h) do { _Pragma("unroll") for (int m = 0; m < 4; ++m) _Pragma("unroll") for (int k = 0; k < 2; ++k) dst[m][k] = *(const PG8_LAS bf16x8*)(lds + PG8_SA(b, h) + aoff + m * 2048 + k * 1024); } while (0)
#define PG8_LDB(dst, b, h) do { _Pragma("unroll") for (int n = 0; n < 2; ++n) _Pragma("unroll") for (int k = 0; k < 2; ++k) dst[n][k] = *(const PG8_LAS bf16x8*)(lds + PG8_SB(b, h) + boff + n * 2048 + k * 1024); } while (0)
#define PG8_MMA(ai, bj, At, Bt) do { __builtin_amdgcn_s_setprio(1); _Pragma("unroll") for (int m = 0; m < 4; ++m) _Pragma("unroll") for (int n = 0; n < 2; ++n) _Pragma("unroll") for (int k = 0; k < 2; ++k) \
        acc[ai][bj][m][n] = __builtin_amdgcn_mfma_f32_16x16x32_bf16(Bt[n][k], At[m][k], acc[ai][bj][m][n], 0, 0, 0); __builtin_amdgcn_s_setprio(0); } while (0)
#define PG8_WAIT_V(n) asm volatile("s_waitcnt vmcnt(" #n ")" ::: "memory")
#define PG8_WAIT_L(n) asm volatile("s_waitcnt lgkmcnt(" #n ")" ::: "memory")
#define PG8_BAR __builtin_amdgcn_s_barrier()
#define PG8_SCHED __builtin_amdgcn_sched_barrier(0)
    Unit cur, nxt; int ui = 0;
    if (!S.next(0, cur)) return;
    f32x4 acc[2][2][4][2];
#pragma unroll
    for (int a = 0; a < 2; ++a)
#pragma unroll
        for (int b = 0; b < 2; ++b)
#pragma unroll
            for (int m = 0; m < 4; ++m)
#pragma unroll
                for (int n = 0; n < 2; ++n) acc[a][b][m][n] = (f32x4){0.f, 0.f, 0.f, 0.f};
    bf16x8 At[4][2], B0[2][2], B1[2][2];
    const char* cA = (const char*)g.A + (size_t)cur.pm * tstep; const char* cB = (const char*)g.Bt + (size_t)cur.pn * tstep;
    S.a_ready(cur);
    if constexpr (SP2) {
        PG8_STAGE(PG8_SB(0, 0), cB, voffB); PG8_STAGE(PG8_SB(0, 1), cB + hstep, voffB); PG8_STAGE(PG8_SA(0, 0), cA, voffA); PG8_STAGE(PG8_SA(0, 1), cA + hstep, voffA);
        if (wr == 1) PG8_BAR;
        PG8_WAIT_V(2); PG8_BAR;
        PG8_STAGE(PG8_SB(1, 0), cB + kstep, voffB); PG8_STAGE(PG8_SA(1, 0), cA + kstep, voffA); PG8_STAGE(PG8_SB(1, 1), cB + hstep + kstep, voffB);
        PG8_WAIT_V(6); PG8_BAR;
    } else {
        PG8_STAGE(PG8_SB(0, 0), cB, voffB); PG8_STAGE(PG8_SA(0, 0), cA, voffA); PG8_STAGE(PG8_SB(0, 1), cB + hstep, voffB); PG8_STAGE(PG8_SA(0, 1), cA + hstep, voffA);
        if (wr == 1) PG8_BAR;
        PG8_WAIT_V(4); PG8_BAR;
        PG8_STAGE(PG8_SB(1, 0), cB + kstep, voffB); PG8_STAGE(PG8_SA(1, 0), cA + kstep, voffA); PG8_STAGE(PG8_SB(1, 1), cB + hstep + kstep, voffB);
        PG8_WAIT_V(6); PG8_BAR;
    }
    for (;;) {
        const bool has_next = S.next(ui + 1, nxt);
        const char* nA = has_next ? (const char*)g.A + (size_t)nxt.pm * tstep : cA; const char* nB = has_next ? (const char*)g.Bt + (size_t)nxt.pn * tstep : cB;
        for (int t = 0; t < nt; t += 2) {
            const bool last = (t == nt - 2);
            const char* a1 = cA + (size_t)(t + 1) * kstep;
            const char* a2 = last ? nA : cA + (size_t)(t + 2) * kstep; const char* b2 = last ? nB : cB + (size_t)(t + 2) * kstep;
            const char* a3 = a2 + kstep; const char* b3 = b2 + kstep;
            if (last && has_next) S.a_ready(nxt);
            if constexpr (SP2) {
            PG8_LDB(B0, 0, 0); PG8_LDB(B1, 0, 1); PG8_SCHED; PG8_LDA(At, 0, 0); PG8_STAGE(PG8_SA(1, 1), a1 + hstep, voffA);
            PG8_WAIT_V(8); PG8_WAIT_L(0); PG8_BAR; PG8_MMA(0, 0, At, B0); PG8_MMA(0, 1, At, B1); PG8_BAR; PG8_SCHED;
            PG8_LDA(At, 0, 1); PG8_STAGE(PG8_SB(0, 0), b2, voffB); PG8_STAGE(PG8_SB(0, 1), b2 + hstep, voffB); PG8_STAGE(PG8_SA(0, 0), a2, voffA);
            PG8_WAIT_V(8); PG8_WAIT_L(0); PG8_BAR; PG8_MMA(1, 0, At, B0); PG8_MMA(1, 1, At, B1); PG8_BAR; PG8_SCHED;
            PG8_LDB(B0, 1, 0); PG8_LDB(B1, 1, 1); PG8_SCHED; PG8_LDA(At, 1, 0); PG8_STAGE(PG8_SA(0, 1), a2 + hstep, voffA);
            PG8_WAIT_V(8); PG8_WAIT_L(0); PG8_BAR; PG8_MMA(0, 0, At, B0); PG8_MMA(0, 1, At, B1); PG8_BAR; PG8_SCHED;
            PG8_LDA(At, 1, 1); PG8_STAGE(PG8_SB(1, 0), b3, voffB); PG8_STAGE(PG8_SB(1, 1), b3 + hstep, voffB); PG8_STAGE(PG8_SA(1, 0), a3, voffA);
            PG8_WAIT_V(8); PG8_WAIT_L(0); PG8_BAR; PG8_MMA(1, 0, At, B0); PG8_MMA(1, 1, At, B1); PG8_BAR; PG8_SCHED;
            } else {
            PG8_LDB(B0, 0, 0); PG8_SCHED; PG8_LDA(At, 0, 0); PG8_STAGE(PG8_SA(1, 1), a1 + hstep, voffA);
            PG8_WAIT_L(8); PG8_BAR; PG8_WAIT_L(0); PG8_MMA(0, 0, At, B0); PG8_BAR; PG8_SCHED;
            PG8_LDB(B1, 0, 1); PG8_STAGE(PG8_SB(0, 0), b2, voffB);
            PG8_BAR; PG8_WAIT_L(0); PG8_MMA(0, 1, At, B1); PG8_BAR;
            PG8_LDA(At, 0, 1); PG8_STAGE(PG8_SA(0, 0), a2, voffA);
            PG8_BAR; PG8_WAIT_L(0); PG8_MMA(1, 0, At, B0); PG8_BAR; PG8_SCHED;
            PG8_STAGE(PG8_SB(0, 1), b2 + hstep, voffB);
            PG8_WAIT_V(6); PG8_BAR; PG8_MMA(1, 1, At, B1); PG8_BAR;
            PG8_LDB(B0, 1, 0); PG8_SCHED; PG8_LDA(At, 1, 0); PG8_STAGE(PG8_SA(0, 1), a2 + hstep, voffA);
            PG8_WAIT_L(8); PG8_BAR; PG8_WAIT_L(0); PG8_MMA(0, 0, At, B0); PG8_BAR; PG8_SCHED;
            PG8_LDB(B1, 1, 1); PG8_STAGE(PG8_SB(1, 0), b3, voffB);
            PG8_BAR; PG8_WAIT_L(0); PG8_MMA(0, 1, At, B1); PG8_BAR;
            PG8_LDA(At, 1, 1); PG8_STAGE(PG8_SA(1, 0), a3, voffA);
            PG8_BAR; PG8_WAIT_L(0); PG8_MMA(1, 0, At, B0); PG8_BAR; PG8_SCHED;
            PG8_STAGE(PG8_SB(1, 1), b3 + hstep, voffB);
            PG8_WAIT_V(6); PG8_BAR; PG8_MMA(1, 1, At, B1); PG8_BAR;
            }
        }
        if constexpr (ALIGN_EPI) { if (wr == 0) PG8_BAR; }
        if constexpr (!Epi::AFTER_DRAIN) { E(acc, cur, wr, wc, fr, fq); S.done(cur); }
        if (!has_next) break;
#pragma unroll
        for (int a = 0; a < 2; ++a)
#pragma unroll
            for (int b = 0; b < 2; ++b)
#pragma unroll
                for (int m = 0; m < 4; ++m)
#pragma unroll
                    for (int n = 0; n < 2; ++n) acc[a][b][m][n] = (f32x4){0.f, 0.f, 0.f, 0.f};
        cur = nxt; cA = nA; cB = nB; ++ui;
        if constexpr (ALIGN_EPI) { if (wr == 1) PG8_BAR; }
    }
    PG8_WAIT_V(0);
    if constexpr (!ALIGN_EPI) { if (wr == 0) PG8_BAR; }
    PG8_BAR;
    if constexpr (Epi::AFTER_DRAIN) { E.fused(acc, cur, wr, wc, fr, fq, lds, wid, lane); S.done(cur); }
#undef PG8_SA
#undef PG8_SB
#undef PG8_STAGE
#undef PG8_LDA
#undef PG8_LDB
#undef PG8_MMA
#undef PG8_WAIT_V
#undef PG8_WAIT_L
#undef PG8_BAR
#undef PG8_SCHED
}
}
constexpr int NWAVES = 8;
constexpr int M = 16384, D = 1024, SEQ = 8192, NIN = 2048, GWID = 512, DFF = 2816, NMEM = 256;
constexpr float EPS = 1e-6f;
constexpr size_t MiB = 1u << 20;
constexpr size_t WS_CTL = 0, CTL_ZERO_BYTES = 256 * 1024;
constexpr size_t WS_MEMN = 1 * MiB, WS_KB = 2 * MiB, WS_VT = 3 * MiB, WS_AGG = 4 * MiB, WS_LRUW = 5 * MiB;
constexpr size_t WS_WIN = 8 * MiB, WS_WKV = 12 * MiB, WS_WOUT = 16 * MiB, WS_WQ = 18 * MiB, WS_WO = 20 * MiB, WS_WGU = 22 * MiB, WS_WDN = 33 * MiB;
constexpr size_t WS_XN = 40 * MiB, WS_Z = 72 * MiB, WS_YCAT = 136 * MiB, WS_Y = 168 * MiB, WS_QO = 200 * MiB, WS_ACT = 72 * MiB, WS_END = 232 * MiB;
constexpr int CW_BAR = 4096, CW_Q = 8192, CW_ROWSS = 16384;
constexpr int RING_BYTES = 131072, LDSCTL_OFF = RING_BYTES, MISC_OFF = LDSCTL_OFF + 320, LDS_BYTES = 147456;

#define GAS __attribute__((address_space(1)))
#define LAS __attribute__((address_space(3)))
typedef unsigned short bf16;
typedef unsigned v4u __attribute__((ext_vector_type(4)));
typedef unsigned v2u __attribute__((ext_vector_type(2)));
typedef float f32x4 __attribute__((ext_vector_type(4)));
typedef short bf16x8 __attribute__((ext_vector_type(8)));
#define LDS_WAIT() asm volatile("s_waitcnt lgkmcnt(0)" ::: "memory")
#define CFENCE() asm volatile("" ::: "memory")
#define SBAR() do { asm volatile("" ::: "memory"); __builtin_amdgcn_sched_barrier(0); } while (0)
__device__ __forceinline__ unsigned pk2(float lo, float hi) { return pg8::cvt_pk_bf16(lo, hi); }
__device__ __forceinline__ float bflo(unsigned w) { return __uint_as_float(w << 16); }
__device__ __forceinline__ float bfhi(unsigned w) { return __uint_as_float(w & 0xffff0000u); }
__device__ __forceinline__ float bf1(unsigned short s) { return __uint_as_float((unsigned)s << 16); }
__device__ __forceinline__ void unpack8(const v4u q, float (&x)[8]) { x[0] = bflo(q.x); x[1] = bfhi(q.x); x[2] = bflo(q.y); x[3] = bfhi(q.y); x[4] = bflo(q.z); x[5] = bfhi(q.z); x[6] = bflo(q.w); x[7] = bfhi(q.w); }
__device__ __forceinline__ bf16x8 pack8(const float (&x)[8]) { v4u w; w.x = pk2(x[0], x[1]); w.y = pk2(x[2], x[3]); w.z = pk2(x[4], x[5]); w.w = pk2(x[6], x[7]); return __builtin_bit_cast(bf16x8, w); }
__device__ __forceinline__ float wave_sum(float v) {
#pragma unroll
    for (int o = 1; o < 64; o <<= 1) v += __shfl_xor(v, o);
    return v;
}
#define MFMA16(a, b, c) __builtin_amdgcn_mfma_f32_16x16x32_bf16((a), (b), (c), 0, 0, 0)

#define XB_TMO      128
#define XB_XCNT(j)  (256  + 64 * (j))
#define XB_XSUB(j)  (1280 + 64 * (j))
#define XB_XGEN(j)  (2304 + 64 * (j))
#define XB_TOP      3328
#define XB_TOPGEN   3392
#define XCD_BAR_WORDS 3456
#define XB_SPIN_CAP (1u << 18)

__device__ __forceinline__ unsigned xb_ld(unsigned* p)              { return __hip_atomic_load(p, __ATOMIC_RELAXED, __HIP_MEMORY_SCOPE_AGENT); }
__device__ __forceinline__ unsigned xb_add(unsigned* p, unsigned v) { return __hip_atomic_fetch_add(p, v, __ATOMIC_RELAXED, __HIP_MEMORY_SCOPE_AGENT); }
__device__ __forceinline__ unsigned xb_xcc_id() { return (unsigned)__builtin_amdgcn_s_getreg((3 << 11) | 20) & 0xFu; }
#define XB_SPIN(cond, bar) do { unsigned _sp = 0; while (cond) { __builtin_amdgcn_s_sleep(1); \
    if ((++_sp & 255u) == 0u) { if (xb_ld(&(bar)[XB_TMO])) break; if (_sp > XB_SPIN_CAP) { atomicAdd(&(bar)[XB_TMO], 1u); break; } } } } while (0)

struct XcdBarrier {
    unsigned* bar; unsigned x;
    volatile LAS unsigned* st;
};

__device__ __forceinline__ XcdBarrier xcd_barrier_post(unsigned* bar, volatile LAS unsigned* st) {
    XcdBarrier b; b.bar = bar; b.x = xb_xcc_id(); b.st = st;
    if (threadIdx.x == 0) (void)xb_add(&bar[XB_XCNT(b.x)], 1u);
    return b;
}
__device__ __forceinline__ void xcd_barrier_complete(unsigned* bar, unsigned x, unsigned& nloc, unsigned& nx) {
    const unsigned G = gridDim.x * gridDim.y * gridDim.z;
    unsigned sum, cnt, mine, sp = 0u;
    for (;;) {
        sum = 0u; cnt = 0u; mine = 0u;
#pragma unroll
        for (unsigned j = 0; j < 16; ++j) { const unsigned c = xb_ld(&bar[XB_XCNT(j)]); sum += c; cnt += (c > 0u) ? 1u : 0u; mine = (j == x) ? c : mine; }
        if (sum == G) break;
        __builtin_amdgcn_s_sleep(1);
        if ((++sp & 255u) == 0u) { if (xb_ld(&bar[XB_TMO])) break; if (sp > XB_SPIN_CAP) { atomicAdd(&bar[XB_TMO], 1u); break; } }
    }
    nloc = mine > 0u ? mine : 1u; nx = cnt > 0u ? cnt : 1u;
}

__device__ __forceinline__ void xcd_barrier(const XcdBarrier& b) {
    asm volatile("s_waitcnt vmcnt(0)" ::: "memory");
    __syncthreads();
    if (threadIdx.x == 0) {
        unsigned* bar = b.bar;
        __builtin_amdgcn_s_waitcnt(0);
        unsigned nloc = b.st[0], nx = b.st[1];
        if (nloc == 0u) { xcd_barrier_complete(bar, b.x, nloc, nx); b.st[0] = nloc; b.st[1] = nx; }
        const unsigned old = xb_add(&bar[XB_XSUB(b.x)], 1u);
        const unsigned gen = old / nloc;
        if (old + 1u == (gen + 1u) * nloc) {
            __builtin_amdgcn_fence(__ATOMIC_RELEASE, "agent");
            asm volatile("s_waitcnt vmcnt(0)" ::: "memory");
            const unsigned og = xb_add(&bar[XB_TOP], 1u);
            const unsigned tg = og / nx;
            if (og + 1u == (tg + 1u) * nx) xb_add(&bar[XB_TOPGEN], 1u);
            else XB_SPIN(xb_ld(&bar[XB_TOPGEN]) == tg, bar);
            __builtin_amdgcn_fence(__ATOMIC_ACQUIRE, "agent");
            xb_add(&bar[XB_XGEN(b.x)], 1u);
            asm volatile("s_waitcnt vmcnt(0)" ::: "memory");
        } else {
            XB_SPIN(xb_ld(&bar[XB_XGEN(b.x)]) == gen, bar);
            __builtin_amdgcn_fence(__ATOMIC_ACQUIRE, "agent");
            asm volatile("s_waitcnt vmcnt(0)" ::: "memory");
        }
    }
    __syncthreads();
}


struct Args { const float* in[30]; float* out; unsigned char* ws; };

__device__ __forceinline__ void p0_transpose_item(const float* W, int K, int N, bf16* WT, int dst_row0, LAS float* scr, int k0, int n0, int lane) {
#pragma unroll 8
    for (int i = 0; i < 32; ++i) { const int kk = 2 * i + (lane >> 5); scr[kk * 33 + (lane & 31)] = W[(size_t)(k0 + kk) * N + n0 + (lane & 31)]; }
    LDS_WAIT(); CFENCE();
    const int c = lane & 7;
#pragma unroll
    for (int j = 0; j < 4; ++j) { const int n = (lane >> 3) + 8 * j; const LAS float* s = scr + (8 * c) * 33 + n;
        v4u o; o.x = pk2(s[0 * 33], s[1 * 33]); o.y = pk2(s[2 * 33], s[3 * 33]); o.z = pk2(s[4 * 33], s[5 * 33]); o.w = pk2(s[6 * 33], s[7 * 33]);
        *(GAS v4u*)(WT + (size_t)(dst_row0 + n) * K + k0 + 8 * c) = o; }
    LDS_WAIT(); CFENCE();
}
__device__ __forceinline__ void rms_row_to_bf16(const float* xrow, const float* g, bf16* orow, int lane) {
    const GAS f32x4* xr = (const GAS f32x4*)xrow + lane; const GAS f32x4* gr = (const GAS f32x4*)g + lane;
    f32x4 v[4]; float s = 0.f;
#pragma unroll
    for (int j = 0; j < 4; ++j) { v[j] = xr[64 * j]; s += (v[j].x * v[j].x + v[j].y * v[j].y) + (v[j].z * v[j].z + v[j].w * v[j].w); }
    const float rstd = 1.0f / sqrtf(wave_sum(s) * (1.f / D) + EPS);
    GAS v2u* o8 = (GAS v2u*)orow + lane;
#pragma unroll
    for (int j = 0; j < 4; ++j) { const f32x4 gg = gr[64 * j]; v2u w; w.x = pk2(v[j].x * rstd * gg.x, v[j].y * rstd * gg.y); w.y = pk2(v[j].z * rstd * gg.z, v[j].w * rstd * gg.w); o8[64 * j] = w; }
}
__device__ __forceinline__ void p0_prologue(LAS unsigned char* lds, const Args& a, int gw, int NGW, int wave, int lane) {
    unsigned char* ws = a.ws;
    LAS float* scr = (LAS float*)(lds + wave * 16384);
    constexpr int I_IN = 16 * 64, I_KV = 16 * 64, I_SQ = 16 * 32, I_G = 16 * 88, I_DN = 44 * 32, I_L = 32;
    constexpr int NITEMS = I_IN + I_KV + 3 * I_SQ + 2 * I_G + I_DN + I_L;
    for (int it = gw; it < NITEMS; it += NGW) {
        int r = it;
        if (r < I_IN) { p0_transpose_item(a.in[2], D, NIN, (bf16*)(ws + WS_WIN), 32 * (r % 64), scr, 64 * (r / 64), 32 * (r % 64), lane); continue; } r -= I_IN;
        if (r < I_KV) { p0_transpose_item(a.in[18], D, 2048, (bf16*)(ws + WS_WKV), 32 * (r % 64), scr, 64 * (r / 64), 32 * (r % 64), lane); continue; } r -= I_KV;
        if (r < I_SQ) { p0_transpose_item(a.in[16], D, D, (bf16*)(ws + WS_WOUT), 32 * (r % 32), scr, 64 * (r / 32), 32 * (r % 32), lane); continue; } r -= I_SQ;
        if (r < I_SQ) { p0_transpose_item(a.in[17], D, D, (bf16*)(ws + WS_WQ), 32 * (r % 32), scr, 64 * (r / 32), 32 * (r % 32), lane); continue; } r -= I_SQ;
        if (r < I_SQ) { p0_transpose_item(a.in[19], D, D, (bf16*)(ws + WS_WO), 32 * (r % 32), scr, 64 * (r / 32), 32 * (r % 32), lane); continue; } r -= I_SQ;
        if (r < 2 * I_G) { const int up = r >= I_G; if (up) r -= I_G; const int n0 = 32 * (r % 88);
            p0_transpose_item(up ? a.in[21] : a.in[20], D, DFF, (bf16*)(ws + WS_WGU), 256 * (n0 / 128) + (n0 % 128) + 128 * up, scr, 64 * (r / 88), n0, lane); continue; } r -= 2 * I_G;
        if (r < I_DN) { p0_transpose_item(a.in[22], DFF, D, (bf16*)(ws + WS_WDN), 32 * (r % 32), scr, 64 * (r / 32), 32 * (r % 32), lane); continue; } r -= I_DN;
        { const int mat = r >> 4, hh = (r >> 1) & 7, nb = r & 1;
          p0_transpose_item((mat ? a.in[11] : a.in[9]) + hh * 4096, 64, 64, (bf16*)(ws + WS_LRUW) + (mat * 8 + hh) * 4096, 32 * nb, scr, 0, 32 * nb, lane); }
    }
    for (int m = gw; m < M; m += NGW) rms_row_to_bf16(a.in[0] + (size_t)m * D, a.in[23], (bf16*)(ws + WS_XN) + (size_t)m * D, lane);
    for (int m = gw; m < 2 * NMEM; m += NGW) rms_row_to_bf16(a.in[1] + (size_t)m * D, a.in[26], (bf16*)(ws + WS_MEMN) + (size_t)m * D, lane);
}
template <bool LAST>
__device__ __forceinline__ void row_pass(const float* hin, const bf16* Y, const float* rowss, const float* gpost, const float* gpre, float* hout, bf16* XN, int gw, int NGW, int lane) {
    for (int row = gw; row < M; row += NGW) {
        const float rstd = 1.0f / sqrtf(rowss[row] * (1.f / D) + EPS);
        const GAS f32x4* hr = (const GAS f32x4*)(hin + (size_t)row * D) + lane; const GAS v2u* yr = (const GAS v2u*)(Y + (size_t)row * D) + lane;
        GAS f32x4* orow = (GAS f32x4*)(hout + (size_t)row * D) + lane;
        f32x4 v[4]; float s = 0.f;
#pragma unroll
        for (int j = 0; j < 4; ++j) { const f32x4 hv = hr[64 * j]; const v2u yw = yr[64 * j]; const f32x4 gg = ((const GAS f32x4*)gpost)[lane + 64 * j];
            v[j].x = hv.x + bflo(yw.x) * rstd * gg.x; v[j].y = hv.y + bfhi(yw.x) * rstd * gg.y; v[j].z = hv.z + bflo(yw.y) * rstd * gg.z; v[j].w = hv.w + bfhi(yw.y) * rstd * gg.w;
            s += (v[j].x * v[j].x + v[j].y * v[j].y) + (v[j].z * v[j].z + v[j].w * v[j].w); orow[64 * j] = v[j]; }
        if (!LAST) {
            const float r2 = 1.0f / sqrtf(wave_sum(s) * (1.f / D) + EPS);
            GAS v2u* o8 = (GAS v2u*)(XN + (size_t)row * D) + lane;
#pragma unroll
            for (int j = 0; j < 4; ++j) { const f32x4 gg = ((const GAS f32x4*)gpre)[lane + 64 * j]; v2u w; w.x = pk2(v[j].x * r2 * gg.x, v[j].y * r2 * gg.y); w.y = pk2(v[j].z * r2 * gg.z, v[j].w * r2 * gg.w); o8[64 * j] = w; }
        }
    }
}

__device__ __forceinline__ void gmlp_item(LAS unsigned char* lds, const Args& a, const bf16* Z, bf16* YCAT, int chunk, int wid, int lane) {
    constexpr int RS = 272;
    LAS float* stat = (LAS float*)lds;
    LAS unsigned char* vt = lds + 1024;
    const int r0 = chunk * 128, fr = lane & 15, fq = lane >> 4;
    const float* ln_g = a.in[3]; const float* ln_b = a.in[4]; const float* w_s = a.in[5]; const float* b_s = a.in[6]; const float* g_out = a.in[14];
    { v4u q[16];
#pragma unroll
      for (int i = 0; i < 16; ++i) q[i] = *(const GAS v4u*)(Z + (size_t)(r0 + 16 * wid + i) * NIN + 512 + 8 * lane);
#pragma unroll
      for (int i = 0; i < 16; ++i) {
        const int t = 16 * wid + i; float x[8];
        unpack8(q[i], x);
        float s = 0.f;
#pragma unroll
        for (int e = 0; e < 8; ++e) s += x[e];
        const float mean = wave_sum(s) * (1.f / GWID); float d2 = 0.f;
#pragma unroll
        for (int e = 0; e < 8; ++e) { const float d = x[e] - mean; d2 += d * d; }
        const float rstd = 1.0f / sqrtf(wave_sum(d2) * (1.f / GWID) + EPS);
        if (lane == 0) { stat[2 * t] = mean; stat[2 * t + 1] = rstd; }
      } }
    __syncthreads();
    float ss = 0.f;
    const int t = 16 * wid + fr; const size_t row = (size_t)(r0 + t);
#pragma unroll
    for (int h = 0; h < 4; ++h) {
        SBAR();
        f32x4 acc[8]; f32x4 wq[4][2]; v2u uq[8];
#pragma unroll
        for (int df = 0; df < 8; ++df) acc[df] = (f32x4){0.f, 0.f, 0.f, 0.f};
#pragma unroll
        for (int oo = 0; oo < 2; ++oo) {
            const int d0 = 8 * (2 * wid + oo), col = 512 + 128 * h + d0; float x0[8], x1[8], gg[8], bb[8];
            unpack8(*(const GAS v4u*)(Z + (size_t)(r0 + 2 * lane) * NIN + col), x0); unpack8(*(const GAS v4u*)(Z + (size_t)(r0 + 2 * lane + 1) * NIN + col), x1);
            const float m0 = stat[4 * lane], rs0 = stat[4 * lane + 1], m1 = stat[4 * lane + 2], rs1 = stat[4 * lane + 3];
            { const f32x4 g0 = *(const GAS f32x4*)(ln_g + 128 * h + d0), g1 = *(const GAS f32x4*)(ln_g + 128 * h + d0 + 4), b0 = *(const GAS f32x4*)(ln_b + 128 * h + d0), b1 = *(const GAS f32x4*)(ln_b + 128 * h + d0 + 4);
#pragma unroll
              for (int e = 0; e < 4; ++e) { gg[e] = g0[e]; gg[4 + e] = g1[e]; bb[e] = b0[e]; bb[4 + e] = b1[e]; } }
#pragma unroll
            for (int e = 0; e < 8; ++e) *(LAS unsigned*)(vt + (d0 + e) * RS + 4 * lane) = pk2((x0[e] - m0) * rs0 * gg[e] + bb[e], (x1[e] - m1) * rs1 * gg[e] + bb[e]);
        }
        SBAR();
#pragma unroll
        for (int ks = 0; ks < 4; ++ks) if (32 * ks <= 16 * wid + 15) { const float* wp = w_s + (size_t)(h * 128 + t) * 128 + 32 * ks + 8 * fq; wq[ks][0] = *(const GAS f32x4*)wp; wq[ks][1] = *(const GAS f32x4*)(wp + 4); }
#pragma unroll
        for (int df = 0; df < 8; ++df) uq[df] = *(const GAS v2u*)(Z + row * NIN + 128 * h + 16 * df + 4 * fq);
        const float bs = b_s[h * 128 + t];
        __syncthreads();
#pragma unroll
        for (int ks = 0; ks < 4; ++ks) {
            if (32 * ks <= 16 * wid + 15) {
                const int p0 = 32 * ks + 8 * fq; float wv[8];
#pragma unroll
                for (int e = 0; e < 4; ++e) { wv[e] = (p0 + e <= t) ? wq[ks][0][e] : 0.f; wv[4 + e] = (p0 + 4 + e <= t) ? wq[ks][1][e] : 0.f; }
                const bf16x8 wf = pack8(wv);
#pragma unroll
                for (int df = 0; df < 8; ++df) { const bf16x8 vf = *(const LAS bf16x8*)(vt + (16 * df + fr) * RS + (32 * ks + 8 * fq) * 2); acc[df] = MFMA16(vf, wf, acc[df]); }
            }
        }
#pragma unroll
        for (int df = 0; df < 8; ++df) { const v2u uw = uq[df];
            const float y0 = bflo(uw.x) * (acc[df][0] + bs), y1 = bfhi(uw.x) * (acc[df][1] + bs), y2 = bflo(uw.y) * (acc[df][2] + bs), y3 = bfhi(uw.y) * (acc[df][3] + bs);
            ss += (y0 * y0 + y1 * y1) + (y2 * y2 + y3 * y3); v2u yw; yw.x = pk2(y0, y1); yw.y = pk2(y2, y3); *(GAS v2u*)(YCAT + row * D + 128 * h + 16 * df + 4 * fq) = yw; }
        __syncthreads();
    }
    ss += __shfl_xor(ss, 16); ss += __shfl_xor(ss, 32);
    const float rstd = 1.0f / sqrtf(ss * (1.f / GWID) + EPS);
    asm volatile("s_waitcnt vmcnt(0)" ::: "memory");
#pragma unroll
    for (int h = 0; h < 4; ++h) {
        SBAR();
        v2u yv[8];
#pragma unroll
        for (int df = 0; df < 8; ++df) yv[df] = *(const GAS v2u*)(YCAT + row * D + 128 * h + 16 * df + 4 * fq);
#pragma unroll
        for (int df = 0; df < 8; ++df) { const int c = 128 * h + 16 * df + 4 * fq; const f32x4 g = *(const GAS f32x4*)(g_out + c); const v2u y = yv[df];
            v2u w; w.x = pk2(bflo(y.x) * rstd * g[0], bfhi(y.x) * rstd * g[1]); w.y = pk2(bflo(y.y) * rstd * g[2], bfhi(y.y) * rstd * g[3]); *(GAS v2u*)(YCAT + row * D + c) = w; }
    }
}

constexpr float LOG2E = 1.4426950408889634f;
__device__ __forceinline__ void lru_scan_frag(const float (&av)[4], const float (&bv)[4], int fr, int fq, float& Al, float& Bl, float& At, float& Bt) {
    Al = av[0]; Bl = bv[0];
#pragma unroll
    for (int i = 1; i < 4; ++i) { Bl = av[i] * Bl + bv[i]; Al *= av[i]; }
    { const float A1 = __shfl_up(Al, 16), B1 = __shfl_up(Bl, 16); if (fq >= 1) { Bl = Al * B1 + Bl; Al = A1 * Al; } }
    { const float A2 = __shfl_up(Al, 32), B2 = __shfl_up(Bl, 32); if (fq >= 2) { Bl = Al * B2 + Bl; Al = A2 * Al; } }
    At = __shfl(Al, fr + 48); Bt = __shfl(Bl, fr + 48);
}
__device__ __forceinline__ void lru_pass0_item(LAS unsigned char* lds, const Args& a, const bf16* Z, const bf16* LRUW, float* AGG, unsigned* LAB, int item, int wid, int lane) {
    constexpr int RS = 144, TILE = 9728;
    const int b = item >> 7, j = item & 127, h = wid, fr = lane & 15, fq = lane >> 4;
    const size_t tok0 = (size_t)b * SEQ + 64 * j;
    LAS unsigned char* tile = lds + wid * TILE;
    const float* conv_w = a.in[7]; const float* conv_b = a.in[8]; const float* b_a = a.in[10]; const float* b_x = a.in[12]; const float* lam = a.in[13];
#pragma unroll
    for (int it = 0; it < 9; ++it) { const int q = lane + 64 * it, rr = q >> 3, ch = q & 7;
        if (rr < 67) { v4u v = (v4u){0u, 0u, 0u, 0u}; if (j > 0 || rr >= 3) v = *(const GAS v4u*)(Z + (tok0 + rr - 3) * NIN + 1024 + 64 * h + 8 * ch); *(LAS v4u*)(tile + rr * RS + 16 * ch) = v; } }
    CFENCE();
    bf16x8 xf[4][2];
#pragma unroll
    for (int ks = 0; ks < 2; ++ks) { const int c0 = 64 * h + 32 * ks + 8 * fq; float cw[4][8], cb[8];
#pragma unroll
        for (int k = 0; k < 4; ++k) { const f32x4 w0 = *(const GAS f32x4*)(conv_w + k * GWID + c0), w1 = *(const GAS f32x4*)(conv_w + k * GWID + c0 + 4);
#pragma unroll
            for (int e = 0; e < 4; ++e) { cw[k][e] = w0[e]; cw[k][4 + e] = w1[e]; } }
        { const f32x4 w0 = *(const GAS f32x4*)(conv_b + c0), w1 = *(const GAS f32x4*)(conv_b + c0 + 4);
#pragma unroll
          for (int e = 0; e < 4; ++e) { cb[e] = w0[e]; cb[4 + e] = w1[e]; } }
#pragma unroll
        for (int tf = 0; tf < 4; ++tf) { float xc[8];
#pragma unroll
            for (int e = 0; e < 8; ++e) xc[e] = cb[e];
#pragma unroll
            for (int k = 0; k < 4; ++k) { float xv[8]; unpack8(*(const LAS v4u*)(tile + (16 * tf + fr + k) * RS + (32 * ks + 8 * fq) * 2), xv);
#pragma unroll
                for (int e = 0; e < 8; ++e) xc[e] += cw[k][e] * xv[e]; }
            xf[tf][ks] = pack8(xc); } }
#pragma unroll
    for (int jf = 0; jf < 4; ++jf) {
        SBAR();
        const int cl = 16 * jf + fr, c = 64 * h + cl;
        bf16x8 wa[2], wx[2], sel;
#pragma unroll
        for (int ks = 0; ks < 2; ++ks) { wa[ks] = *(const GAS bf16x8*)(LRUW + (size_t)((0 * 8 + h) * 64 + cl) * 64 + 32 * ks + 8 * fq); wx[ks] = *(const GAS bf16x8*)(LRUW + (size_t)((1 * 8 + h) * 64 + cl) * 64 + 32 * ks + 8 * fq); }
        { const int kp = 16 * (jf & 1) + fr;
#pragma unroll
          for (int e = 0; e < 8; ++e) sel[e] = (short)((fq == (kp >> 3) && e == (kp & 7)) ? 0x3f80 : 0); }
        const float ba = b_a[c], bx = b_x[c], sp8 = -8.0f * log1pf(expf(-lam[c]));
        float Ac = 1.f, Bc = 0.f;
#pragma unroll
        for (int tf = 0; tf < 4; ++tf) {
            const f32x4 z4 = (f32x4){0.f, 0.f, 0.f, 0.f};
            f32x4 aR = MFMA16(xf[tf][0], wa[0], z4), aI = MFMA16(xf[tf][0], wx[0], z4); aR = MFMA16(xf[tf][1], wa[1], aR); aI = MFMA16(xf[tf][1], wx[1], aI);
            const f32x4 xc4 = MFMA16(xf[tf][jf >> 1], sel, z4);
            float av[4], bv[4];
#pragma unroll
            for (int i = 0; i < 4; ++i) { const float rg = pg8::sigmoid1(aR[i] + ba), ig = pg8::sigmoid1(aI[i] + bx), la = rg * sp8, x = 2.0f * la;
                float p = 1.0f + x * (1.0f / 6.0f); p = 1.0f + x * 0.2f * p; p = 1.0f + x * 0.25f * p; p = 1.0f + x * (1.0f / 3.0f) * p; p = 1.0f + x * 0.5f * p;
                const float bt = __builtin_amdgcn_sqrtf(-x * p) * (ig * xc4[i]);
                const unsigned w = pk2(la, bt);
                LAB[(tok0 + 16 * tf + 4 * fq + i) * GWID + c] = w;
                av[i] = __builtin_amdgcn_exp2f(bflo(w) * LOG2E); bv[i] = bfhi(w); }
            float Al, Bl, At, Bt; lru_scan_frag(av, bv, fr, fq, Al, Bl, At, Bt);
            Bc = At * Bc + Bt; Ac = Ac * At;
        }
        if (fq == 0) { float* ag = AGG + ((size_t)(b * 128 + j) * 2) * GWID + c; ag[0] = Ac; ag[GWID] = Bc; }
    }
}
__device__ __forceinline__ void lru_pass1_item(LAS unsigned char* lds, const Args& a, const bf16* Z, const float* AGG, const unsigned* LAB, bf16* YCAT, int item, int wid, int lane) {
    constexpr int RS = 144, TILE = 9728;
    const int b = item >> 7, j = item & 127, h = wid, fr = lane & 15, fq = lane >> 4;
    const size_t tok0 = (size_t)b * SEQ + 64 * j;
    LAS unsigned char* tile = lds + wid * TILE;
    LAS float* part = (LAS float*)(lds + 8 * TILE);
    const float* g_lru = a.in[15];
#pragma unroll
    for (int it = 0; it < 8; ++it) { const int q = lane + 64 * it, rr = q >> 3, ch = q & 7; *(LAS v4u*)(tile + rr * RS + 16 * ch) = *(const GAS v4u*)(Z + (tok0 + rr) * NIN + 1536 + 64 * h + 8 * ch); }
    float hfold = 0.f;
    { const float* ag = AGG + (size_t)b * 128 * 2 * GWID + 64 * h + lane; int q = 0;
      for (; q + 16 <= j; q += 16) { float A[16], Bv[16];
#pragma unroll
          for (int e = 0; e < 16; ++e) { A[e] = ag[(size_t)(2 * (q + e)) * GWID]; Bv[e] = ag[(size_t)(2 * (q + e) + 1) * GWID]; }
#pragma unroll
          for (int e = 0; e < 16; ++e) hfold = A[e] * hfold + Bv[e]; }
      for (; q < j; ++q) hfold = ag[(size_t)(2 * q) * GWID] * hfold + ag[(size_t)(2 * q + 1) * GWID]; }
    CFENCE();
    float ssq[4][4];
#pragma unroll
    for (int tf = 0; tf < 4; ++tf)
#pragma unroll
        for (int i = 0; i < 4; ++i) ssq[tf][i] = 0.f;
#pragma unroll
    for (int jf = 0; jf < 4; ++jf) {
        SBAR();
        const int cl = 16 * jf + fr, c = 64 * h + cl;
        unsigned w[4][4];
#pragma unroll
        for (int tf = 0; tf < 4; ++tf)
#pragma unroll
            for (int i = 0; i < 4; ++i) w[tf][i] = LAB[(tok0 + 16 * tf + 4 * fq + i) * GWID + c];
        float hc = __shfl(hfold, cl);
#pragma unroll
        for (int tf = 0; tf < 4; ++tf) {
            float av[4], bv[4];
#pragma unroll
            for (int i = 0; i < 4; ++i) { av[i] = __builtin_amdgcn_exp2f(bflo(w[tf][i]) * LOG2E); bv[i] = bfhi(w[tf][i]); }
            float Al, Bl, At, Bt; lru_scan_frag(av, bv, fr, fq, Al, Bl, At, Bt);
            float Ae = __shfl_up(Al, 16), Be = __shfl_up(Bl, 16); if (fq == 0) { Ae = 1.f; Be = 0.f; }
            float hh = Ae * hc + Be;
#pragma unroll
            for (int i = 0; i < 4; ++i) { hh = av[i] * hh + bv[i];
                LAS unsigned short* gp = (LAS unsigned short*)(tile + (16 * tf + 4 * fq + i) * RS + cl * 2);
                const float y = bf1(*gp) * hh; ssq[tf][i] += y * y; *gp = (unsigned short)(pk2(y, 0.f) & 0xffffu); }
            hc = At * hc + Bt;
        }
    }
    SBAR();
#pragma unroll
    for (int tf = 0; tf < 4; ++tf)
#pragma unroll
        for (int i = 0; i < 4; ++i) { float s = ssq[tf][i]; s += __shfl_xor(s, 1); s += __shfl_xor(s, 2); s += __shfl_xor(s, 4); s += __shfl_xor(s, 8);
            if (fr == 0) part[(16 * tf + 4 * fq + i) * 8 + wid] = s; }
    __syncthreads();
    float rstd;
    { const f32x4 p0 = *(const LAS f32x4*)(part + lane * 8), p1 = *(const LAS f32x4*)(part + lane * 8 + 4);
      rstd = 1.0f / sqrtf(((p0[0] + p0[1]) + (p0[2] + p0[3]) + (p1[0] + p1[1]) + (p1[2] + p1[3])) * (1.f / GWID) + EPS); }
    float gl[8];
    { const int c0 = 64 * h + 8 * (lane & 7); const f32x4 g0 = *(const GAS f32x4*)(g_lru + c0), g1 = *(const GAS f32x4*)(g_lru + c0 + 4);
#pragma unroll
      for (int e = 0; e < 4; ++e) { gl[e] = g0[e]; gl[4 + e] = g1[e]; } }
#pragma unroll
    for (int it = 0; it < 8; ++it) { const int q = lane + 64 * it, rr = q >> 3, ch = q & 7; const float rs = __shfl(rstd, rr); float y[8];
        unpack8(*(const LAS v4u*)(tile + rr * RS + 16 * ch), y);
#pragma unroll
        for (int e = 0; e < 8; ++e) y[e] = y[e] * rs * gl[e];
        *(GAS bf16x8*)(YCAT + (tok0 + rr) * D + 512 + 64 * h + 8 * ch) = pack8(y); }
    __syncthreads();
}

__device__ __forceinline__ void attn_item(LAS unsigned char* lds, const bf16* KB, const bf16* VT, const bf16* QO, bf16* OO, int item, int tid, int wid, int lane) {
    const int tile = item & 31, h = (item >> 5) & 3, b = item >> 7, fr = lane & 15, fq = lane >> 4;
#pragma unroll 4
    for (int it = 0; it < 16; ++it) { const int q = tid + 512 * it, m = q >> 5, c = q & 31;
        *(LAS v4u*)(lds + m * 512 + ((c ^ (m & 15)) << 4)) = *(const GAS v4u*)(KB + (size_t)(b * NMEM + m) * D + h * 256 + 8 * c); }
    __syncthreads();
    bf16x8 pf[2][8]; float inv[2];
#pragma unroll
    for (int s = 0; s < 2; ++s) {
        const size_t row = (size_t)b * SEQ + tile * 256 + 128 * s + 16 * wid + fr;
        f32x4 S[16];
#pragma unroll
        for (int mf = 0; mf < 16; ++mf) S[mf] = (f32x4){0.f, 0.f, 0.f, 0.f};
#pragma unroll
        for (int ks = 0; ks < 8; ++ks) { const bf16x8 qf = *(const GAS bf16x8*)(QO + row * D + h * 256 + 32 * ks + 8 * fq);
#pragma unroll
            for (int mf = 0; mf < 16; ++mf) { const bf16x8 kf = *(const LAS bf16x8*)(lds + (16 * mf + fr) * 512 + (((4 * ks + fq) ^ fr) << 4)); S[mf] = MFMA16(kf, qf, S[mf]); } }
        float mx = S[0][0];
#pragma unroll
        for (int mf = 0; mf < 16; ++mf)
#pragma unroll
            for (int e = 0; e < 4; ++e) mx = fmaxf(mx, S[mf][e]);
        mx = fmaxf(mx, __shfl_xor(mx, 16)); mx = fmaxf(mx, __shfl_xor(mx, 32));
        float sum = 0.f;
#pragma unroll
        for (int mf = 0; mf < 16; ++mf)
#pragma unroll
            for (int e = 0; e < 4; ++e) { const float p = __builtin_amdgcn_exp2f((S[mf][e] - mx) * 1.4426950408889634f); S[mf][e] = p; sum += p; }
        sum += __shfl_xor(sum, 16); sum += __shfl_xor(sum, 32); inv[s] = 1.0f / sum;
#pragma unroll
        for (int ks = 0; ks < 8; ++ks) { v4u w; w.x = pk2(S[2 * ks][0], S[2 * ks][1]); w.y = pk2(S[2 * ks][2], S[2 * ks][3]); w.z = pk2(S[2 * ks + 1][0], S[2 * ks + 1][1]); w.w = pk2(S[2 * ks + 1][2], S[2 * ks + 1][3]);
            pf[s][ks] = __builtin_bit_cast(bf16x8, w); }
    }
    __syncthreads();
#pragma unroll 4
    for (int it = 0; it < 16; ++it) { const int q = tid + 512 * it, d = q >> 5, c = q & 31;
        *(LAS v4u*)(lds + d * 512 + ((c ^ (d & 15)) << 4)) = *(const GAS v4u*)(VT + ((size_t)b * D + h * 256 + d) * NMEM + 8 * c); }
    __syncthreads();
#pragma unroll
    for (int s = 0; s < 2; ++s) {
        const size_t row = (size_t)b * SEQ + tile * 256 + 128 * s + 16 * wid + fr;
        f32x4 O[16];
#pragma unroll
        for (int df = 0; df < 16; ++df) O[df] = (f32x4){0.f, 0.f, 0.f, 0.f};
#pragma unroll
        for (int ks = 0; ks < 8; ++ks)
#pragma unroll
            for (int df = 0; df < 16; ++df) { const bf16x8 vf = *(const LAS bf16x8*)(lds + (16 * df + fr) * 512 + (((4 * ks + fq) ^ fr) << 4)); O[df] = MFMA16(vf, pf[s][ks], O[df]); }
#pragma unroll
        for (int df = 0; df < 16; ++df) { v2u w; w.x = pk2(O[df][0] * inv[s], O[df][1] * inv[s]); w.y = pk2(O[df][2] * inv[s], O[df][3] * inv[s]); *(GAS v2u*)(OO + row * D + h * 256 + 16 * df + 4 * fq) = w; }
    }
    __syncthreads();
}

#ifndef R0
#define R0 1
#endif
#ifndef R2
#define R2 1
#endif
#ifndef R3
#define R3 1
#endif
#ifndef R7
#define R7 1
#endif
#ifndef RB
#define RB 0
#endif
#define REPEAT(n) for (int rep_ = 0; rep_ < (n); ++rep_)
__global__ void __launch_bounds__(NWAVES * 64, 2) hybrid_fwd(Args args) {
    extern __shared__ __attribute__((aligned(16))) unsigned char lds_raw[];
    LAS unsigned char* lds = (LAS unsigned char*)lds_raw;
    volatile LAS unsigned* MISC = (volatile LAS unsigned*)(lds + MISC_OFF);
    const int G = gridDim.x, bx = blockIdx.x, NGW = G * NWAVES;
    unsigned char* ws = args.ws;
    unsigned* ctl = (unsigned*)(ws + WS_CTL);
    float* rowss = (float*)(ctl + CW_ROWSS);
    bf16* XN = (bf16*)(ws + WS_XN); bf16* Z = (bf16*)(ws + WS_Z); bf16* YCAT = (bf16*)(ws + WS_YCAT); bf16* Y = (bf16*)(ws + WS_Y); bf16* QO = (bf16*)(ws + WS_QO); bf16* ACT = (bf16*)(ws + WS_ACT);
    bf16* MEMN = (bf16*)(ws + WS_MEMN); bf16* KB = (bf16*)(ws + WS_KB); bf16* VT = (bf16*)(ws + WS_VT); float* AGG = (float*)(ws + WS_AGG); bf16* LRUW = (bf16*)(ws + WS_LRUW); unsigned* LAB = (unsigned*)(ws + WS_QO);
    for (int u = threadIdx.x; u < (LDS_BYTES - LDSCTL_OFF) / 4; u += NWAVES * 64) ((LAS unsigned*)(lds + LDSCTL_OFF))[u] = 0u;
    __syncthreads();
    XcdBarrier bar = xcd_barrier_post(ctl + CW_BAR, MISC + 8);
#define GRID_BAR() xcd_barrier(bar)
#define FRESH() int tid = threadIdx.x; asm volatile("" : "+v"(tid)); const int lane = tid & 63, wave = __builtin_amdgcn_readfirstlane(tid >> 6), gw = bx * NWAVES + wave; (void)lane; (void)gw

    REPEAT(R0) { { FRESH(); p0_prologue(lds, args, gw, NGW, wave, lane); }
    GRID_BAR(); }
    REPEAT(RB) GRID_BAR();
    { pg8::Gemm g{XN, (const bf16*)(ws + WS_WIN), M, NIN, D}; pg8::StaticOrder S; S.init(M, NIN, G, bx); pg8::EpiBf E{Z, NIN, 0xCFu, 1.0f};
      pg8::gemm_phase<pg8::EpiBf, pg8::StaticOrder, true, true>(lds, g, S, E); }
    GRID_BAR();
    { pg8::Gemm g{MEMN, (const bf16*)(ws + WS_WKV), 2 * NMEM, 2048, D}; pg8::StaticOrder S; S.init(2 * NMEM, 2048, G, bx); pg8::EpiKV E{KB, VT};
      pg8::gemm_phase<pg8::EpiKV, pg8::StaticOrder, true, true>(lds, g, S, E); }
    for (;;) {
        __syncthreads();
        if (threadIdx.x == 0) MISC[16] = __hip_atomic_fetch_add(ctl + CW_Q, 1u, __ATOMIC_RELAXED, __HIP_MEMORY_SCOPE_AGENT);
        __syncthreads();
        const int idx = (int)MISC[16];
        if (idx >= 128 + M / 64) break;
        FRESH();
        if (idx < 128) gmlp_item(lds, args, Z, YCAT, idx, wave, lane);
        else lru_pass0_item(lds, args, Z, LRUW, AGG, LAB, idx - 128, wave, lane);
    }
    GRID_BAR();
    REPEAT(R3) { for (int it = bx; it < M / 64; it += G) { FRESH(); lru_pass1_item(lds, args, Z, AGG, LAB, YCAT, it, wave, lane); }
    GRID_BAR(); }
    { pg8::Gemm g{YCAT, (const bf16*)(ws + WS_WOUT), M, D, D}; pg8::StaticOrder S; S.init(M, D, G, bx); pg8::EpiYss E{Y, D, rowss};
      pg8::gemm_phase<pg8::EpiYss, pg8::StaticOrder, true, true>(lds, g, S, E); }
    GRID_BAR();
    { FRESH(); row_pass<false>(args.in[0], Y, rowss, args.in[24], args.in[25], args.out, XN, gw, NGW, lane); }
    GRID_BAR();
    { pg8::Gemm g{XN, (const bf16*)(ws + WS_WQ), M, D, D}; pg8::StaticOrder S; S.init(M, D, G, bx); pg8::EpiBf E{QO, D, 0u, 0.0625f};
      pg8::gemm_phase<pg8::EpiBf, pg8::StaticOrder, true, true>(lds, g, S, E); }
    GRID_BAR();
    REPEAT(R7) { for (int it = bx; it < 256; it += G) { FRESH(); attn_item(lds, KB, VT, QO, YCAT, it, tid, wave, lane); }
    GRID_BAR(); }
    { pg8::Gemm g{YCAT, (const bf16*)(ws + WS_WO), M, D, D}; pg8::StaticOrder S; S.init(M, D, G, bx); pg8::EpiYss E{Y, D, rowss + M};
      pg8::gemm_phase<pg8::EpiYss, pg8::StaticOrder, true, true>(lds, g, S, E); }
    GRID_BAR();
    { FRESH(); row_pass<false>(args.out, Y, rowss + M, args.in[27], args.in[28], args.out, XN, gw, NGW, lane); }
    GRID_BAR();
    { pg8::Gemm g{XN, (const bf16*)(ws + WS_WGU), M, 2 * DFF, D}; pg8::StaticOrder S; S.init(M, 2 * DFF, G, bx); pg8::EpiGU E{ACT, DFF};
      pg8::gemm_phase<pg8::EpiGU, pg8::StaticOrder, true, true>(lds, g, S, E); }
    GRID_BAR();
    { pg8::Gemm g{ACT, (const bf16*)(ws + WS_WDN), M, D, DFF}; pg8::StaticOrder S; S.init(M, D, G, bx); pg8::EpiYss E{Y, D, rowss + 2 * M};
      pg8::gemm_phase<pg8::EpiYss, pg8::StaticOrder, true, true>(lds, g, S, E); }
    GRID_BAR();
    { FRESH(); row_pass<true>(args.out, Y, rowss + 2 * M, args.in[29], nullptr, args.out, nullptr, gw, NGW, lane); }
}

extern "C" void kernel_launch(void* const* d_in, const int* in_sizes, int n_in, void* d_out, int out_size, void* d_ws, size_t ws_size, hipStream_t stream) {
    static int grid = 0;
    if (grid == 0) {
        if (n_in != 30 || in_sizes[0] != M * D || out_size != M * D || ws_size < WS_END) { fprintf(stderr, "kernel_launch: unexpected problem shape (n_in %d, in0 %d, out %d, ws %zu)\n", n_in, n_in > 0 ? in_sizes[0] : -1, out_size, ws_size); grid = -1; return; }
        int dev = 0, cus = 0, per_cu = 0;
        if (hipGetDevice(&dev) != hipSuccess || hipDeviceGetAttribute(&cus, hipDeviceAttributeMultiprocessorCount, dev) != hipSuccess) { grid = -1; return; }
        if (hipFuncSetAttribute((const void*)hybrid_fwd, hipFuncAttributeMaxDynamicSharedMemorySize, LDS_BYTES) != hipSuccess) { fprintf(stderr, "kernel_launch: hipFuncSetAttribute failed\n"); grid = -1; return; }
        if (hipOccupancyMaxActiveBlocksPerMultiprocessor(&per_cu, (const void*)hybrid_fwd, NWAVES * 64, LDS_BYTES) != hipSuccess || per_cu < 1) { fprintf(stderr, "kernel_launch: occupancy query says %d blocks per CU\n", per_cu); grid = -1; return; }
        grid = cus;
    }
    if (grid < 0) return;
    (void)hipMemsetAsync((char*)d_ws + WS_CTL, 0, CTL_ZERO_BYTES, stream);
    Args a{};
    for (int i = 0; i < 30; ++i) a.in[i] = (const float*)d_in[i];
    a.out = (float*)d_out; a.ws = (unsigned char*)d_ws;
    void* kargs[] = {&a};
    hipError_t e = hipLaunchCooperativeKernel((const void*)hybrid_fwd, dim3(grid), dim3(NWAVES * 64), kargs, LDS_BYTES, stream);
    if (e != hipSuccess) fprintf(stderr, "kernel_launch: cooperative launch failed: %s (grid %d)\n", hipGetErrorString(e), grid);
}
```
